# Optimizing an MI355X kernel written in HIP

```python
import math
import numpy as np
import jax
import jax.numpy as jnp
from jax import lax

D_MODEL = 1024
BATCH = 8
SEQ = 2048
DEPTH = 4

D_MIX = D_MODEL
HEAD_DIM = 64
FOX_WIDTH = D_MIX // 4
DIL_WIDTH = D_MIX // 4
HGRN_WIDTH = D_MIX // 2
FOX_HEADS = FOX_WIDTH // HEAD_DIM
DIL_HEADS = DIL_WIDTH // HEAD_DIM
HGRN_EXPAND = 128
HGRN_HEADS = HGRN_WIDTH // HGRN_EXPAND
HGRN_VDIM = HGRN_WIDTH // HGRN_HEADS
HGRN_FDIM = HGRN_HEADS * HGRN_EXPAND
HGRN_CHUNK = 64
Q_BLOCK = 128
DILATED_PATTERNS = ((128, 1), (512, 4), (2048, 16))
ROPE_DIM = HEAD_DIM // 4
ROPE_THETA = 500000.0
D_FF = ((8 * D_MODEL // 3 + 127) // 128) * 128
EPS = 1e-6
NEG_BIG = -1e30
LB_FLOOR = 1e-30

SPLIT_SIZES = (FOX_WIDTH, FOX_WIDTH, FOX_WIDTH, FOX_HEADS,
               DIL_WIDTH, DIL_WIDTH, DIL_WIDTH,
               HGRN_FDIM, HGRN_FDIM, HGRN_WIDTH, HGRN_WIDTH)
N_IN = sum(SPLIT_SIZES)
SPLIT_POINTS = tuple(int(s) for s in np.cumsum(SPLIT_SIZES)[:-1])

kernel_name = "hybrid_fox_dilated_hgrn2_macaron"


def _rmsnorm(x, g):
    xf = x.astype(jnp.float32)
    y = xf * lax.rsqrt(jnp.mean(xf * xf, axis=-1, keepdims=True) + EPS)
    return (y * g.astype(jnp.float32)).astype(x.dtype)


def _swiglu(h, wg, wu, wd):
    return (jax.nn.silu(h @ wg) * (h @ wu)) @ wd


def _partial_rope(t, positions):
    half = ROPE_DIM // 2
    freqs = ROPE_THETA ** (-jnp.arange(0, ROPE_DIM, 2, dtype=jnp.float32) / ROPE_DIM)
    ang = positions.astype(jnp.float32)[:, :, None] * freqs
    cos = jnp.cos(ang)[:, :, None, :]
    sin = jnp.sin(ang)[:, :, None, :]
    tf = t.astype(jnp.float32)
    x1, x2, rest = tf[..., :half], tf[..., half:ROPE_DIM], tf[..., ROPE_DIM:]
    out = jnp.concatenate([x1 * cos - x2 * sin, x2 * cos + x1 * sin, rest], axis=-1)
    return out.astype(t.dtype)


def _fox_attention(q, k, v, c):
    B, H, T, dh = q.shape
    nb = T // Q_BLOCK
    scale = dh ** -0.5
    qb = q.reshape(B, H, nb, Q_BLOCK, dh).transpose(2, 0, 1, 3, 4)
    cb = c.reshape(B, H, nb, Q_BLOCK).transpose(2, 0, 1, 3)
    kpos = jnp.arange(T)

    def block(args):
        qi, ci, n = args
        s = jnp.einsum('bhqd,bhkd->bhqk', qi, k).astype(jnp.float32) * scale
        s = s + ci[..., None] - c[:, :, None, :]
        qpos = n * Q_BLOCK + jnp.arange(Q_BLOCK)
        mask = kpos[None, :] <= qpos[:, None]
        p = jax.nn.softmax(jnp.where(mask, s, NEG_BIG), axis=-1)
        return jnp.einsum('bhqk,bhkd->bhqd', p.astype(v.dtype), v)

    out = lax.map(block, (qb, cb, jnp.arange(nb)))
    return out.transpose(1, 2, 0, 3, 4).reshape(B, H, T, dh)


def _dilated_branch(q, k, v, window, dilation):
    B, H, T, dh = q.shape
    L = T // dilation
    w = window // dilation
    blk = min(w, L)
    nb = -(-L // blk)
    Lp = nb * blk
    scale = dh ** -0.5

    def to_blocks(t):
        t = t.reshape(B, H, L, dilation, dh).transpose(0, 1, 3, 2, 4)
        t = jnp.pad(t, ((0, 0), (0, 0), (0, 0), (0, Lp - L), (0, 0)))
        return t.reshape(B, H, dilation, nb, blk, dh)

    def with_prev(t):
        prev = jnp.pad(t, ((0, 0), (0, 0), (0, 0), (1, 0), (0, 0), (0, 0)))[:, :, :, :nb]
        return jnp.concatenate([prev, t], axis=4)

    qb = to_blocks(q)
    kc = with_prev(to_blocks(k))
    vc = with_prev(to_blocks(v))
    s = jnp.einsum('bhrnqd,bhrnkd->bhrnqk', qb, kc).astype(jnp.float32) * scale
    i = jnp.arange(blk)[:, None]
    j = jnp.arange(2 * blk)[None, :]
    rel = blk + i - j
    first = (jnp.arange(nb)[:, None, None] == 0) & (j < blk)[None]
    mask = ((rel >= 0) & (rel <= w))[None] & ~first
    s = jnp.where(mask, s, NEG_BIG)
    m = jnp.max(s, axis=-1, keepdims=True)
    p = jnp.exp(s - m)
    den = jnp.sum(p, axis=-1)
    o = jnp.einsum('bhrnqk,bhrnkd->bhrnqd', p, vc.astype(jnp.float32)) / den[..., None]
    lse = m[..., 0] + jnp.log(den)
    o = o.reshape(B, H, dilation, Lp, dh)[:, :, :, :L].transpose(0, 1, 3, 2, 4).reshape(B, H, T, dh)
    lse = lse.reshape(B, H, dilation, Lp)[..., :L].transpose(0, 1, 3, 2).reshape(B, H, T)
    return o, lse


def _dilated_attention(q, k, v):
    outs, lses = [], []
    for window, dilation in DILATED_PATTERNS:
        o, lse = _dilated_branch(q, k, v, window, dilation)
        outs.append(o)
        lses.append(lse)
    wts = jax.nn.softmax(jnp.stack(lses, 0), axis=0)
    return jnp.sum(wts[..., None] * jnp.stack(outs, 0), axis=0)


def _hgrn2(q_raw, f_raw, i_raw, g_raw, lb, norm_w):
    B, T, _ = q_raw.shape
    H, E, V, C = HGRN_HEADS, HGRN_EXPAND, HGRN_VDIM, HGRN_CHUNK
    nc = T // C
    lbf = jnp.clip(lb.astype(jnp.float32), 0.0, 1.0 - 1e-6)
    z = f_raw.astype(jnp.float32)
    log_f = jnp.logaddexp(jnp.log(jnp.maximum(lbf, LB_FLOOR)),
                          jnp.log1p(-lbf) + jax.nn.log_sigmoid(z))
    kk = (1.0 - lbf) * jax.nn.sigmoid(-z)
    qq = jax.nn.silu(q_raw.astype(jnp.float32))
    vv = i_raw.astype(jnp.float32)

    def chunks(t, d):
        return t.reshape(B, nc, C, H, d).transpose(1, 0, 3, 2, 4)

    causal = jnp.arange(C)[:, None] >= jnp.arange(C)[None, :]

    def step(S, inp):
        q, k, v, lf = inp
        b = jnp.cumsum(lf, axis=2)
        inter = jnp.einsum('bhte,bhev->bhtv', q * jnp.exp(b), S)
        diff = b[:, :, :, None, :] - b[:, :, None, :, :]
        D = jnp.exp(jnp.where(causal[None, None, :, :, None], diff, NEG_BIG))
        A = jnp.einsum('bhtse,bhse->bhts', q[:, :, :, None, :] * D, k)
        intra = jnp.einsum('bhts,bhsv->bhtv', A, v)
        b_last = b[:, :, -1, :]
        S_new = jnp.exp(b_last)[..., None] * S + jnp.einsum(
            'bhse,bhsv->bhev', k * jnp.exp(b_last[:, :, None, :] - b), v)
        return S_new, inter + intra

    S0 = jnp.zeros((B, H, E, V), jnp.float32)
    _, o = lax.scan(step, S0, (chunks(qq, E), chunks(kk, E), chunks(vv, V), chunks(log_f, E)))
    o = o.transpose(1, 0, 3, 2, 4).reshape(B, T, H, V)
    o = o * lax.rsqrt(jnp.mean(o * o, axis=-1, keepdims=True) + EPS)
    o = o.reshape(B, T, H * V) * norm_w.astype(jnp.float32)
    return o * jax.nn.sigmoid(g_raw.astype(jnp.float32))


def _mixing(h, positions, w_in, w_out, fox_b, lb, hgrn_norm):
    B, T, _ = h.shape
    proj = h @ w_in
    (fq, fk, fv, ff, dq, dk, dv, hq, hf, hi, hg) = jnp.split(proj, SPLIT_POINTS, axis=-1)

    def heads(t, n):
        return t.reshape(B, T, n, HEAD_DIM)

    log_fg = jax.nn.log_sigmoid((ff + fox_b).astype(jnp.float32))
    c = jnp.cumsum(log_fg, axis=1).transpose(0, 2, 1)
    tr = lambda t: t.transpose(0, 2, 1, 3)
    oa = _fox_attention(tr(heads(fq, FOX_HEADS)), tr(heads(fk, FOX_HEADS)),
                        tr(heads(fv, FOX_HEADS)), c)
    oa = oa.transpose(0, 2, 1, 3).reshape(B, T, FOX_WIDTH)

    qd = _partial_rope(heads(dq, DIL_HEADS), positions)
    kd = _partial_rope(heads(dk, DIL_HEADS), positions)
    ob = _dilated_attention(tr(qd), tr(kd), tr(heads(dv, DIL_HEADS)))
    ob = ob.transpose(0, 2, 1, 3).reshape(B, T, DIL_WIDTH)

    oc = _hgrn2(hq, hf, hi, hg, lb, hgrn_norm)

    o = jnp.concatenate([oa.astype(h.dtype), ob.astype(h.dtype), oc.astype(h.dtype)], axis=-1)
    return o @ w_out


def setup_inputs(seed: int = 0) -> dict:
    key = jax.random.key(seed)
    ks = jax.random.split(key, 20)
    f32 = jnp.float32
    nrm = lambda k, shape, fan: jax.random.normal(k, shape, f32) * fan ** -0.5
    gain = lambda k, shape: 1.0 + 0.02 * jax.random.normal(k, shape, f32)
    x = jax.random.normal(ks[0], (BATCH, SEQ, D_MODEL), f32)
    positions = jnp.broadcast_to(jnp.arange(SEQ, dtype=jnp.int32)[None, :], (BATCH, SEQ))
    return {
        "x": x,
        "positions": positions,
        "ffn1_norm": gain(ks[1], (DEPTH, D_MODEL)),
        "ffn1_w_gate": nrm(ks[2], (DEPTH, D_MODEL, D_FF), D_MODEL),
        "ffn1_w_up": nrm(ks[3], (DEPTH, D_MODEL, D_FF), D_MODEL),
        "ffn1_w_down": nrm(ks[4], (DEPTH, D_FF, D_MODEL), D_FF),
        "mix_norm": gain(ks[5], (DEPTH, D_MODEL)),
        "w_in": nrm(ks[6], (DEPTH, D_MODEL, N_IN), D_MODEL),
        "fox_forget_bias": 2.0 + 0.5 * jax.random.normal(ks[7], (DEPTH, FOX_HEADS), f32),
        "hgrn_lower_bounds": 0.1 * jax.random.normal(ks[8], (DEPTH, HGRN_FDIM), f32),
        "hgrn_out_norm": gain(ks[9], (DEPTH, HGRN_WIDTH)),
        "w_out": nrm(ks[10], (DEPTH, D_MIX, D_MODEL), D_MIX),
        "ffn2_norm": gain(ks[11], (DEPTH, D_MODEL)),
        "ffn2_w_gate": nrm(ks[12], (DEPTH, D_MODEL, D_FF), D_MODEL),
        "ffn2_w_up": nrm(ks[13], (DEPTH, D_MODEL, D_FF), D_MODEL),
        "ffn2_w_down": nrm(ks[14], (DEPTH, D_FF, D_MODEL), D_FF),
        "final_norm": gain(ks[15], (D_MODEL,)),
    }


def reference(x, positions, ffn1_norm, ffn1_w_gate, ffn1_w_up, ffn1_w_down, mix_norm, w_in,
              fox_forget_bias, hgrn_lower_bounds, hgrn_out_norm, w_out, ffn2_norm,
              ffn2_w_gate, ffn2_w_up, ffn2_w_down, final_norm):
    sm = jax.nn.softmax(hgrn_lower_bounds.astype(jnp.float32), axis=0)
    lbs = jnp.cumsum(sm, axis=0) - sm[0:1]
    for i in range(DEPTH):
        h = _rmsnorm(x, ffn1_norm[i])
        x = x + 0.5 * _swiglu(h, ffn1_w_gate[i], ffn1_w_up[i], ffn1_w_down[i])
        h = _rmsnorm(x, mix_norm[i])
        x = x + _mixing(h, positions, w_in[i], w_out[i], fox_forget_bias[i], lbs[i],
                        hgrn_out_norm[i])
        h = _rmsnorm(x, ffn2_norm[i])
        x = x + 0.5 * _swiglu(h, ffn2_w_gate[i], ffn2_w_up[i], ffn2_w_down[i])
    return _rmsnorm(x, final_norm)
```

```cpp
#include <hip/hip_runtime.h>
#include <hip/hip_cooperative_groups.h>
#include <cstdio>
#include <cstdint>
namespace cg = cooperative_groups;

#define DI __device__ __forceinline__
typedef unsigned short bf16_t;
typedef short bf16x8 __attribute__((ext_vector_type(8)));
typedef float f32x4 __attribute__((ext_vector_type(4)));
typedef unsigned u32x4 __attribute__((ext_vector_type(4)));
typedef unsigned u32x2 __attribute__((ext_vector_type(2)));

constexpr int BATCH = 8, T = 2048, D = 1024, DEPTH = 4, M = BATCH * T, DFF = 2816, NIN = 3588, LD = 3840;
constexpr int NGU = 2 * DFF;
constexpr int C_FQ = 0, C_DQ = 256, C_HQ = 512, C_FK = 1024, C_FV = 1280, C_DK = 1536, C_DV = 1792, C_HF = 2048, C_HI = 2560, C_HG = 3072, C_FF = 3584;
constexpr int S_FQ = 0, S_FK = 256, S_FV = 512, S_FF = 768, S_DQ = 772, S_DK = 1028, S_DV = 1284, S_HQ = 1540, S_HF = 2052, S_HI = 2564, S_HG = 3076;
constexpr float EPS = 1e-6f;

constexpr size_t MiB = 1u << 20;
constexpr size_t WS_CTL = 0, WS_SSQ = 1 * MiB, WS_ROPE = 2 * MiB, WS_FFB = 3 * MiB, WS_CARR = 3 * MiB + 256 * 1024, WS_LBS = 3 * MiB + 512 * 1024, WS_DEC = 4 * MiB;
constexpr size_t WS_W = 6 * MiB, W_LAYER = 42 * MiB + 512 * 1024;
constexpr size_t WO_GU1 = 0, WO_D1 = 11 * MiB, WO_IN = 16 * MiB + 512 * 1024, WO_OUT = 24 * MiB, WO_GU2 = 26 * MiB, WO_D2 = 37 * MiB;
constexpr size_t WS_XB = 176 * MiB, WS_PROJ = 208 * MiB, WS_Q1 = 328 * MiB, WS_K2T = 344 * MiB, WS_VT = 360 * MiB, WS_AM = 376 * MiB, WS_END = 384 * MiB;
static_assert(WS_W + 4 * W_LAYER <= WS_XB && WS_XB + (size_t)M * D * 2 <= WS_PROJ && WS_PROJ + (size_t)M * LD * 2 <= WS_Q1, "ws map");

constexpr int LDS_BYTES = 147456;

DI float bf2f(unsigned short h) { return __uint_as_float(((unsigned)h) << 16); }
DI unsigned cvt_pk_bf16(float lo, float hi) { unsigned r; asm("v_cvt_pk_bf16_f32 %0, %1, %2" : "=v"(r) : "v"(lo), "v"(hi)); return r; }
DI float fast_sigmoid(float x) { return __builtin_amdgcn_rcpf(1.f + __expf(-x)); }

namespace pg8 {
#define PG8_LAS __attribute__((address_space(3)))
constexpr int BM = 256, BK = 64, HALF = 128, HTB = HALF * BK * 2, STAGE_BYTES = 8 * HTB, NXCD = 8, WGM = 8;
__host__ __device__ __forceinline__ int lds_byte(int r, int c) { const int st = (r >> 4) * 2 + (c >> 5), rr = r & 15, cc = c & 31, ob = rr * 64 + cc * 2; return st * 1024 + (ob ^ (((ob >> 9) & 1) << 5)); }
__host__ __device__ __forceinline__ void stage_rc(int b, int& R, int& C) { const int st = b / 1024, sb = b % 1024, swz = sb ^ (((sb >> 9) & 1) << 5); R = (st >> 1) * 16 + swz / 64; C = (st & 1) * 32 + (swz % 64) / 2; }
__host__ __device__ __forceinline__ int perm32(int rho) { const int n = rho >> 4, i = rho & 15; return 8 * (i >> 2) + 4 * n + (i & 3); }

struct Unit { int pm, pn; };
struct Gemm { const bf16_t* A; const bf16_t* Bt; int M, N, K, lda, ldb; };

struct StaticOrder {
    int nM, nN, nwg, G, c;
    __host__ __device__ void init(int M_, int N_, int G_, int c_) { nM = M_ / BM; nN = N_ / BM; nwg = nM * nN; G = G_; c = c_; }
    __host__ __device__ bool next(int i, Unit& u) const {
        const long L = (long)i * G + c; if (L >= nwg) return false;
        int wgid = (int)L; { const int q = nwg / NXCD, r = nwg % NXCD, xcd = wgid % NXCD, off = wgid / NXCD; wgid = (xcd < r ? xcd * (q + 1) : r * (q + 1) + (xcd - r) * q) + off; }
        const int nig = WGM * nN, gid = wgid / nig, fm = gid * WGM, gsz = (nM - fm) < WGM ? (nM - fm) : WGM;
        u.pm = fm + ((wgid % nig) % gsz); u.pn = (wgid % nig) / gsz; return true;
    }
};

template <class Epi, bool ALIGN_EPI>
__device__ __forceinline__ void gemm_phase(PG8_LAS unsigned char* lds, const Gemm g, const StaticOrder& S, const Epi& E, const int tid) {
    const int wid = __builtin_amdgcn_readfirstlane(tid >> 6), lane = tid & 63, wr = wid >> 2, wc = wid & 3, fr = lane & 15, fq = lane >> 4;
    const int K = g.K, nt = K / BK;
    unsigned voffA[2], voffB[2];
#pragma unroll
    for (int i = 0; i < 2; ++i) { int R, C; stage_rc(tid * 16 + i * 8192, R, C); const int Rb = (R & ~31) + perm32(R & 31);
        voffA[i] = (unsigned)(R * g.lda + C) * 2u; voffB[i] = (unsigned)(Rb * g.ldb + C) * 2u; }
    const size_t kstep = (size_t)(BK * 2);
    const size_t hA = (size_t)HALF * g.lda * 2, hB = (size_t)HALF * g.ldb * 2, tA = 2 * hA, tB = 2 * hB;
    const unsigned ldsw = (unsigned)wid * 1024u;
    const int aoff = lds_byte(wr * 64 + fr, fq * 8), boff = lds_byte(wc * 32 + fr, fq * 8);
#define PG8_SA(b, h) (((b) * 2 + (h)) * HTB)
#define PG8_SB(b, h) ((4 + (b) * 2 + (h)) * HTB)
#define PG8_STAGE(bufoff, gbase, voff) do { _Pragma("unroll") for (int _i = 0; _i < 2; ++_i) \
        __builtin_amdgcn_global_load_lds((const unsigned*)((const char*)(gbase) + (voff)[_i]), (PG8_LAS unsigned*)(lds + (bufoff) + ldsw + _i * 8192), 16, 0, 0); } while (0)
#define PG8_LDA(dst, b, h) do { _Pragma("unroll") for (int m = 0; m < 4; ++m) _Pragma("unroll") for (int k = 0; k < 2; ++k) dst[m][k] = *(const PG8_LAS bf16x8*)(lds + PG8_SA(b, h) + aoff + m * 2048 + k * 1024); } while (0)
#define PG8_LDB(dst, b, h) do { _Pragma("unroll") for (int n = 0; n < 2; ++n) _Pragma("unroll") for (int k = 0; k < 2; ++k) dst[n][k] = *(const PG8_LAS bf16x8*)(lds + PG8_SB(b, h) + boff + n * 2048 + k * 1024); } while (0)
#define PG8_MMA(ai, bj, At, Bt) do { __builtin_amdgcn_s_setprio(1); _Pragma("unroll") for (int m = 0; m < 4; ++m) _Pragma("unroll") for (int n = 0; n < 2; ++n) _Pragma("unroll") for (int k = 0; k < 2; ++k) \
        acc[ai][bj][m][n] = __builtin_amdgcn_mfma_f32_16x16x32_bf16(Bt[n][k], At[m][k], acc[ai][bj][m][n], 0, 0, 0); __builtin_amdgcn_s_setprio(0); } while (0)
#define PG8_WAIT_V(n) asm volatile("s_waitcnt vmcnt(" #n ")" ::: "memory")
#define PG8_WAIT_L(n) asm volatile("s_waitcnt lgkmcnt(" #n ")" ::: "memory")
#define PG8_BAR __builtin_amdgcn_s_barrier()
#define PG8_SCHED __builtin_amdgcn_sched_barrier(0)
    Unit cur, nxt; int ui = 0;
    if (!S.next(0, cur)) return;
    f32x4 acc[2][2][4][2];
#pragma unroll
    for (int a = 0; a < 2; ++a)
#pragma unroll
        for (int b = 0; b < 2; ++b)
#pragma unroll
            for (int m = 0; m < 4; ++m)
#pragma unroll
                for (int n = 0; n < 2; ++n) acc[a][b][m][n] = (f32x4){0.f, 0.f, 0.f, 0.f};
    bf16x8 At[4][2], B0[2][2], B1[2][2];
    const char* cA = (const char*)g.A + (size_t)cur.pm * tA; const char* cB = (const char*)g.Bt + (size_t)cur.pn * tB;
    PG8_STAGE(PG8_SB(0, 0), cB, voffB); PG8_STAGE(PG8_SB(0, 1), cB + hB, voffB); PG8_STAGE(PG8_SA(0, 0), cA, voffA); PG8_STAGE(PG8_SA(0, 1), cA + hA, voffA);
    if (wr == 1) PG8_BAR;
    PG8_WAIT_V(2); PG8_BAR;
    PG8_STAGE(PG8_SB(1, 0), cB + kstep, voffB); PG8_STAGE(PG8_SA(1, 0), cA + kstep, voffA); PG8_STAGE(PG8_SB(1, 1), cB + hB + kstep, voffB);
    PG8_WAIT_V(6); PG8_BAR;
    for (;;) {
        const bool has_next = S.next(ui + 1, nxt);
        const char* nA = has_next ? (const char*)g.A + (size_t)nxt.pm * tA : cA; const char* nB = has_next ? (const char*)g.Bt + (size_t)nxt.pn * tB : cB;
        for (int t = 0; t < nt; t += 2) {
            const bool last = (t == nt - 2);
            const char* a1 = cA + (size_t)(t + 1) * kstep;
            const char* a2 = last ? nA : cA + (size_t)(t + 2) * kstep; const char* b2 = last ? nB : cB + (size_t)(t + 2) * kstep;
            const char* a3 = a2 + kstep; const char* b3 = b2 + kstep;
            PG8_LDB(B0, 0, 0); PG8_LDB(B1, 0, 1); PG8_SCHED; PG8_LDA(At, 0, 0); PG8_STAGE(PG8_SA(1, 1), a1 + hA, voffA);
            PG8_WAIT_V(8); PG8_WAIT_L(0); PG8_BAR; PG8_MMA(0, 0, At, B0); PG8_MMA(0, 1, At, B1); PG8_BAR; PG8_SCHED;
            PG8_LDA(At, 0, 1); PG8_STAGE(PG8_SB(0, 0), b2, voffB); PG8_STAGE(PG8_SB(0, 1), b2 + hB, voffB); PG8_STAGE(PG8_SA(0, 0), a2, voffA);
            PG8_WAIT_V(8); PG8_WAIT_L(0); PG8_BAR; PG8_MMA(1, 0, At, B0); PG8_MMA(1, 1, At, B1); PG8_BAR; PG8_SCHED;
            PG8_LDB(B0, 1, 0); PG8_LDB(B1, 1, 1); PG8_SCHED; PG8_LDA(At, 1, 0); PG8_STAGE(PG8_SA(0, 1), a2 + hA, voffA);
            PG8_WAIT_V(8); PG8_WAIT_L(0); PG8_BAR; PG8_MMA(0, 0, At, B0); PG8_MMA(0, 1, At, B1); PG8_BAR; PG8_SCHED;
            PG8_LDA(At, 1, 1); PG8_STAGE(PG8_SB(1, 0), b3, voffB); PG8_STAGE(PG8_SB(1, 1), b3 + hB, voffB); PG8_STAGE(PG8_SA(1, 0), a3, voffA);
            PG8_WAIT_V(8); PG8_WAIT_L(0); PG8_BAR; PG8_MMA(1, 0, At, B0); PG8_MMA(1, 1, At, B1); PG8_BAR; PG8_SCHED;
        }
        if constexpr (ALIGN_EPI) { if (wr == 0) PG8_BAR; }
        E(acc, cur, wr, wc, fr, fq);
        if (!has_next) break;
#pragma unroll
        for (int a = 0; a < 2; ++a)
#pragma unroll
            for (int b = 0; b < 2; ++b)
#pragma unroll
                for (int m = 0; m < 4; ++m)
#pragma unroll
                    for (int n = 0; n < 2; ++n) acc[a][b][m][n] = (f32x4){0.f, 0.f, 0.f, 0.f};
        cur = nxt; cA = nA; cB = nB; ++ui;
        if constexpr (ALIGN_EPI) { if (wr == 1) PG8_BAR; }
    }
    PG8_WAIT_V(0);
    if constexpr (!ALIGN_EPI) { if (wr == 0) PG8_BAR; }
    PG8_BAR;
#undef PG8_SA
#undef PG8_SB
#undef PG8_STAGE
#undef PG8_LDA
#undef PG8_LDB
#undef PG8_MMA
#undef PG8_WAIT_V
#undef PG8_WAIT_L
#undef PG8_BAR
#undef PG8_SCHED
}
}

DI float row_rs(const float* ssq, int row) {
    const f32x4* p = (const f32x4*)(ssq + (size_t)row * 16);
    const f32x4 a = p[0], b = p[1], c = p[2], d = p[3];
    const float s = ((a[0] + a[1]) + (a[2] + a[3])) + ((b[0] + b[1]) + (b[2] + b[3])) + ((c[0] + c[1]) + (c[2] + c[3])) + ((d[0] + d[1]) + (d[2] + d[3]));
    return __builtin_amdgcn_rsqf(s * (1.0f / D) + EPS);
}

struct EpiSwiGLU {
    bf16_t* H; const float* ssq;
    DI void operator()(const f32x4 (&acc)[2][2][4][2], const pg8::Unit& u, int wr, int wc, int fr, int fq) const {
        const int row0 = u.pm * 256 + wr * 64 + fr, col = u.pn * 128 + wc * 32 + 8 * fq;
#pragma unroll
        for (int ai = 0; ai < 2; ++ai)
#pragma unroll
            for (int m = 0; m < 4; ++m) {
                const int row = row0 + ai * 128 + m * 16; const float r = row_rs(ssq, row);
                float hv[8];
#pragma unroll
                for (int n = 0; n < 2; ++n)
#pragma unroll
                    for (int i = 0; i < 4; ++i) { const float gg = acc[ai][0][m][n][i] * r, uu = acc[ai][1][m][n][i] * r; hv[n * 4 + i] = gg * fast_sigmoid(gg) * uu; }
                u32x4 w; w.x = cvt_pk_bf16(hv[0], hv[1]); w.y = cvt_pk_bf16(hv[2], hv[3]); w.z = cvt_pk_bf16(hv[4], hv[5]); w.w = cvt_pk_bf16(hv[6], hv[7]);
                *(u32x4*)(H + (size_t)row * DFF + col) = w;
            }
    }
};

struct EpiResid {
    const float* base; float* out; bf16_t* xb; float* ssq; float alpha;
    DI void operator()(const f32x4 (&acc)[2][2][4][2], const pg8::Unit& u, int wr, int wc, int fr, int fq) const {
        const int row0 = u.pm * 256 + wr * 64 + fr, col0 = u.pn * 256 + wc * 32 + 8 * fq;
#pragma unroll
        for (int ai = 0; ai < 2; ++ai)
#pragma unroll
            for (int m = 0; m < 4; ++m) {
                const int row = row0 + ai * 128 + m * 16; float ss = 0.f;
#pragma unroll
                for (int bj = 0; bj < 2; ++bj) {
                    const size_t off = (size_t)row * D + col0 + bj * 128;
                    const f32x4 x0 = *(const f32x4*)(base + off), x1 = *(const f32x4*)(base + off + 4);
                    const f32x4 y0 = x0 + acc[ai][bj][m][0] * alpha, y1 = x1 + acc[ai][bj][m][1] * alpha;
                    *(f32x4*)(out + off) = y0; *(f32x4*)(out + off + 4) = y1;
                    u32x4 w; w.x = cvt_pk_bf16(y0[0], y0[1]); w.y = cvt_pk_bf16(y0[2], y0[3]); w.z = cvt_pk_bf16(y1[0], y1[1]); w.w = cvt_pk_bf16(y1[2], y1[3]);
                    *(u32x4*)(xb + off) = w;
                    ss += (y0[0] * y0[0] + y0[1] * y0[1]) + (y0[2] * y0[2] + y0[3] * y0[3]) + (y1[0] * y1[0] + y1[1] * y1[1]) + (y1[2] * y1[2] + y1[3] * y1[3]);
                }
                ss += __shfl_xor(ss, 16); ss += __shfl_xor(ss, 32);
                if (fq == 0) ssq[(size_t)row * 16 + u.pn * 4 + wc] = ss;
            }
    }
};

struct EpiProj {
    bf16_t* P; const float* ssq; const float* rope; float* ffb;
    DI void operator()(const f32x4 (&acc)[2][2][4][2], const pg8::Unit& u, int wr, int wc, int fr, int fq) const {
        const int row0 = u.pm * 256 + wr * 64 + fr, colw = wc * 32 + 8 * fq;
        const bool rot = (u.pn == 1 || u.pn == 6) && ((colw & 63) < 16);
        const int ra = ((colw & 63) == 0) ? 0 : 4;
#pragma unroll
        for (int ai = 0; ai < 2; ++ai)
#pragma unroll
            for (int m = 0; m < 4; ++m) {
                const int row = row0 + ai * 128 + m * 16; const float r = row_rs(ssq, row);
                if (u.pn == 14) { if (wc == 0 && fq == 0) *(f32x4*)(ffb + (size_t)row * 4) = acc[ai][0][m][0] * r; continue; }
                f32x4 cs = {1.f, 1.f, 1.f, 1.f}, sn = {0.f, 0.f, 0.f, 0.f};
                if (rot) { cs = *(const f32x4*)(rope + (size_t)row * 16 + ra); sn = *(const f32x4*)(rope + (size_t)row * 16 + 8 + ra); }
#pragma unroll
                for (int bj = 0; bj < 2; ++bj) {
                    const f32x4 v0 = acc[ai][bj][m][0] * r, v1 = acc[ai][bj][m][1] * r;
                    const f32x4 o0 = v0 * cs - v1 * sn, o1 = v1 * cs + v0 * sn;
                    u32x4 w; w.x = cvt_pk_bf16(o0[0], o0[1]); w.y = cvt_pk_bf16(o0[2], o0[3]); w.z = cvt_pk_bf16(o1[0], o1[1]); w.w = cvt_pk_bf16(o1[2], o1[3]);
                    *(u32x4*)(P + (size_t)row * LD + u.pn * 256 + bj * 128 + colw) = w;
                }
            }
    }
};

DI int rope_perm(int j) { return (j >= 4 && j < 8) ? j + 4 : ((j >= 8 && j < 12) ? j - 4 : j); }
DI int win_src(int d) {
    if (d < 256) return S_FQ + d;
    if (d < 512) { const int j = d - 256; return S_DQ + (j & ~63) + rope_perm(j & 63); }
    if (d < 1024) return S_HQ + (d - 512);
    if (d < 1280) return S_FK + (d - 1024);
    if (d < 1536) return S_FV + (d - 1280);
    if (d < 1792) { const int j = d - 1536; return S_DK + (j & ~63) + rope_perm(j & 63); }
    if (d < 2048) return S_DV + (d - 1792);
    if (d < 2560) return S_HF + (d - 2048);
    if (d < 3072) return S_HI + (d - 2560);
    if (d < 3584) return S_HG + (d - 3072);
    if (d < 3588) return S_FF + (d - 3584);
    return -1;
}
DI void conv_item(const float* W, int N, int K, const float* gk, bf16_t* WT, int drow0, int mode, int src0, int kb, float* scr, int lane) {
    const int k0 = 64 * kb, n = lane & 31;
    const int sc = mode == 0 ? src0 + n : win_src(drow0 + n);
#pragma unroll 8
    for (int i = 0; i < 32; ++i) { const int kk = 2 * i + (lane >> 5); float v = 0.f; if (sc >= 0) v = W[(size_t)(k0 + kk) * N + sc]; if (gk) v *= gk[k0 + kk]; scr[kk * 33 + n] = v; }
    asm volatile("s_waitcnt lgkmcnt(0)" ::: "memory");
    const int c = lane & 7;
#pragma unroll
    for (int j = 0; j < 4; ++j) { const int nn = (lane >> 3) + 8 * j; const float* s = scr + (8 * c) * 33 + nn;
        u32x4 o; o.x = cvt_pk_bf16(s[0 * 33], s[1 * 33]); o.y = cvt_pk_bf16(s[2 * 33], s[3 * 33]); o.z = cvt_pk_bf16(s[4 * 33], s[5 * 33]); o.w = cvt_pk_bf16(s[6 * 33], s[7 * 33]);
        *(u32x4*)(WT + (size_t)(drow0 + nn) * K + k0 + 8 * c) = o; }
    asm volatile("s_waitcnt lgkmcnt(0)" ::: "memory");
}

struct Args {
    const float* x; const int* pos;
    const float *f1n, *f1g, *f1u, *f1d, *mn, *win, *fb, *hlb, *hon, *wout, *f2n, *f2g, *f2u, *f2d, *fn;
    float* out; unsigned char* ws;
};

DI void sincos_d(double x, float& s, float& c) {
    const double k = __builtin_rint(x * 0.63661977236758134308);
    const double r = (x - k * 1.5707963267948966192) - k * 6.123233995736766e-17;
    const double r2 = r * r;
    double sp = r * (1.0 + r2 * (-1.0 / 6 + r2 * (1.0 / 120 + r2 * (-1.0 / 5040 + r2 * (1.0 / 362880 + r2 * (-1.0 / 39916800))))));
    double cp = 1.0 + r2 * (-0.5 + r2 * (1.0 / 24 + r2 * (-1.0 / 720 + r2 * (1.0 / 40320 + r2 * (-1.0 / 3628800 + r2 * (1.0 / 479001600))))));
    const int q = ((int)k) & 3;
    const double ss = (q == 0) ? sp : (q == 1) ? cp : (q == 2) ? -sp : -cp;
    const double cc = (q == 0) ? cp : (q == 1) ? -sp : (q == 2) ? -cp : sp;
    s = (float)ss; c = (float)cc;
}

DI void prologue(const Args& a, unsigned char* lds, int tid, int lane, int wave) {
    unsigned char* ws = a.ws;
    const int gw = blockIdx.x * 8 + wave, NGW = gridDim.x * 8;
    float* scr = (float*)(lds + wave * 16384);
    constexpr int I_GU = 16 * (NGU / 32), I_D = (DFF / 64) * (D / 32), I_IN = 16 * (LD / 32), I_OUT = 16 * (D / 32);
    constexpr int I_LAYER = 2 * I_GU + 2 * I_D + I_IN + I_OUT;
    for (int it = gw; it < DEPTH * I_LAYER; it += NGW) {
        const int l = it / I_LAYER; int r = it % I_LAYER;
        unsigned char* wl = ws + WS_W + (size_t)l * W_LAYER;
        if (r < 2 * I_GU) {
            const int f = r >= I_GU; if (f) r -= I_GU;
            const int rb = r >> 4, kb = r & 15, d0 = rb * 32, pn = d0 >> 8, within = d0 & 255;
            const float* Wg = (f ? a.f2g : a.f1g) + (size_t)l * D * DFF; const float* Wu = (f ? a.f2u : a.f1u) + (size_t)l * D * DFF;
            const float* gk = (f ? a.f2n : a.f1n) + (size_t)l * D;
            conv_item(within < 128 ? Wg : Wu, DFF, D, gk, (bf16_t*)(wl + (f ? WO_GU2 : WO_GU1)), d0, 0, 128 * pn + (within & 127), kb, scr, lane);
            continue;
        }
        r -= 2 * I_GU;
        if (r < 2 * I_D) {
            const int f = r >= I_D; if (f) r -= I_D;
            const int rb = r / (DFF / 64), kb = r % (DFF / 64);
            conv_item((f ? a.f2d : a.f1d) + (size_t)l * DFF * D, D, DFF, nullptr, (bf16_t*)(wl + (f ? WO_D2 : WO_D1)), rb * 32, 0, rb * 32, kb, scr, lane);
            continue;
        }
        r -= 2 * I_D;
        if (r < I_IN) { const int rb = r >> 4, kb = r & 15;
            conv_item(a.win + (size_t)l * D * NIN, NIN, D, a.mn + (size_t)l * D, (bf16_t*)(wl + WO_IN), rb * 32, 1, 0, kb, scr, lane); continue; }
        r -= I_IN;
        { const int rb = r >> 4, kb = r & 15; conv_item(a.wout + (size_t)l * D * D, D, D, nullptr, (bf16_t*)(wl + WO_OUT), rb * 32, 0, rb * 32, kb, scr, lane); }
    }
    bf16_t* xb = (bf16_t*)(ws + WS_XB); float* ssq = (float*)(ws + WS_SSQ);
    for (int m = gw; m < M; m += NGW) {
        const f32x4* xr = (const f32x4*)(a.x + (size_t)m * D) + lane; float s = 0.f;
        u32x2* o8 = (u32x2*)(xb + (size_t)m * D) + lane;
#pragma unroll
        for (int j = 0; j < 4; ++j) { const f32x4 v = xr[64 * j]; s += (v[0] * v[0] + v[1] * v[1]) + (v[2] * v[2] + v[3] * v[3]); u32x2 w; w.x = cvt_pk_bf16(v[0], v[1]); w.y = cvt_pk_bf16(v[2], v[3]); o8[64 * j] = w; }
#pragma unroll
        for (int o = 1; o < 64; o <<= 1) s += __shfl_xor(s, o);
        if (lane < 16) ssq[(size_t)m * 16 + lane] = lane == 0 ? s : 0.f;
    }
    float* rope = (float*)(ws + WS_ROPE);
    for (int i = blockIdx.x * 512 + tid; i < M * 8; i += gridDim.x * 512) {
        const int m = i >> 3, fi = i & 7;
        const float freq = exp2f(-(float)fi * 0.125f * 18.931568569324174f);
        const float ang = (float)a.pos[m] * freq;
        float s, c; sincos_d((double)ang, s, c);
        rope[(size_t)m * 16 + fi] = c; rope[(size_t)m * 16 + 8 + fi] = s;
    }
    if (blockIdx.x == 0) {
        float* lbs = (float*)(ws + WS_LBS); const int j = tid;
        float v[DEPTH], mx = -1e30f, sum = 0.f;
#pragma unroll
        for (int l = 0; l < DEPTH; ++l) { v[l] = a.hlb[l * 512 + j]; mx = fmaxf(mx, v[l]); }
#pragma unroll
        for (int l = 0; l < DEPTH; ++l) { v[l] = expf(v[l] - mx); sum += v[l]; }
        float run = 0.f;
#pragma unroll
        for (int l = 0; l < DEPTH; ++l) { if (l > 0) run += v[l] / sum; lbs[l * 512 + j] = fminf(fmaxf(run, 0.f), 1.0f - 1e-6f); }
    }
}

DI float log_sigmoid(float z) { return fminf(z, 0.f) - __logf(1.f + __expf(-fabsf(z))); }

DI void fox_scan(const Args& a, int layer, int bh, unsigned char* lds, int tid, int lane, int wave) {
    const int b = bh >> 2, h = bh & 3;
    const float* ffb = (const float*)(a.ws + WS_FFB); float* carr = (float*)(a.ws + WS_CARR) + (size_t)bh * T;
    const float bias = a.fb[layer * 4 + h];
    float v[4], run = 0.f;
#pragma unroll
    for (int j = 0; j < 4; ++j) { const int t = tid * 4 + j; run += log_sigmoid(ffb[(size_t)(b * T + t) * 4 + h] + bias); v[j] = run; }
    float inc = run;
#pragma unroll
    for (int o = 1; o < 64; o <<= 1) { const float up = __shfl_up(inc, o); if (lane >= o) inc += up; }
    float* wt = (float*)lds;
    if (lane == 63) wt[wave] = inc;
    __syncthreads();
    float pre = inc - run;
    for (int w = 0; w < wave; ++w) pre += wt[w];
    f32x4 o = {v[0] + pre, v[1] + pre, v[2] + pre, v[3] + pre};
    *(f32x4*)(carr + tid * 4) = o;
    __syncthreads();
}

DI void hgrn_prep(const Args& a, int layer, int item, unsigned char* lds, int tid, int lane, int wave) {
    const int bh = item >> 5, c = item & 31, b = bh >> 2, h = bh & 3, m0 = b * T + c * 64;
    const bf16_t* P = (const bf16_t*)(a.ws + WS_PROJ) + (size_t)m0 * LD;
    bf16_t* Q1 = (bf16_t*)(a.ws + WS_Q1) + (size_t)item * 8192; bf16_t* K2T = (bf16_t*)(a.ws + WS_K2T) + (size_t)item * 8192;
    bf16_t* VT = (bf16_t*)(a.ws + WS_VT) + (size_t)item * 8192; bf16_t* AM = (bf16_t*)(a.ws + WS_AM) + (size_t)item * 4096;
    float* DEC = (float*)(a.ws + WS_DEC) + (size_t)item * 128;
    bf16_t* qmL = (bf16_t*)lds; bf16_t* kmL = (bf16_t*)(lds + 17408); float* tot = (float*)(lds + 34816);
    const int e = tid & 127, qd = tid >> 7;
    const float lb = ((const float*)(a.ws + WS_LBS))[layer * 512 + h * 128 + e];
    const float la = __logf(fmaxf(lb, 1e-30f)), l1 = log1pf(-lb), oml = 1.f - lb;
    float bl[16], kq[16], qq[16]; float run = 0.f;
#pragma unroll
    for (int j = 0; j < 16; ++j) {
        const int s = 16 * qd + j;
        const float z = bf2f(P[(size_t)s * LD + C_HF + h * 128 + e]);
        const float ez = __expf(-fabsf(z)), lsz = fminf(z, 0.f) - __logf(1.f + ez);
        const float b2 = l1 + lsz, mx = fmaxf(la, b2), lf = mx + __logf(1.f + __expf(-fabsf(la - b2)));
        run += lf; bl[j] = run;
        const float rc = __builtin_amdgcn_rcpf(1.f + ez);
        kq[j] = oml * (z >= 0.f ? ez * rc : rc);
        const float hq = bf2f(P[(size_t)s * LD + C_HQ + h * 128 + e]);
        qq[j] = hq * fast_sigmoid(hq);
    }
    tot[qd * 128 + e] = run;
    __syncthreads();
    const float t0 = tot[e], t1 = tot[128 + e], t2 = tot[256 + e], t3 = tot[384 + e];
    const float off = (qd > 0 ? t0 : 0.f) + (qd > 1 ? t1 : 0.f) + (qd > 2 ? t2 : 0.f);
    const float blast = ((t0 + t1) + t2) + t3, rmid = t0 + t1;
    unsigned k2p[8]; float k2prev = 0.f;
#pragma unroll
    for (int j = 0; j < 16; ++j) {
        const int s = 16 * qd + j; const float bb = bl[j] + off;
        const float q1 = qq[j] * __expf(bb), qm = qq[j] * __expf(fminf(bb - rmid, 80.f)), km = kq[j] * __expf(fminf(rmid - bb, 80.f)), k2 = kq[j] * __expf(blast - bb);
        Q1[s * 128 + e] = (bf16_t)(cvt_pk_bf16(q1, 0.f) & 0xffffu);
        qmL[s * 136 + e] = (bf16_t)(cvt_pk_bf16(qm, 0.f) & 0xffffu);
        kmL[s * 136 + e] = (bf16_t)(cvt_pk_bf16(km, 0.f) & 0xffffu);
        if (j & 1) k2p[j >> 1] = cvt_pk_bf16(k2prev, k2); else k2prev = k2;
    }
    { u32x4 w0 = {k2p[0], k2p[1], k2p[2], k2p[3]}, w1 = {k2p[4], k2p[5], k2p[6], k2p[7]};
      *(u32x4*)(K2T + e * 64 + 16 * qd) = w0; *(u32x4*)(K2T + e * 64 + 16 * qd + 8) = w1; }
    if (qd == 0) DEC[e] = __expf(blast);
    { unsigned vp[8]; unsigned prev = 0;
#pragma unroll
      for (int j = 0; j < 16; ++j) { const unsigned hv = P[(size_t)(16 * qd + j) * LD + C_HI + h * 128 + e]; if (j & 1) vp[j >> 1] = prev | (hv << 16); else prev = hv; }
      u32x4 w0 = {vp[0], vp[1], vp[2], vp[3]}, w1 = {vp[4], vp[5], vp[6], vp[7]};
      *(u32x4*)(VT + e * 64 + 16 * qd) = w0; *(u32x4*)(VT + e * 64 + 16 * qd + 8) = w1; }
    __syncthreads();
    const int r = lane & 15, g = lane >> 4;
#pragma unroll
    for (int q = 0; q < 2; ++q) {
        const int id = 2 * wave + q, tt = id >> 2, st = id & 3;
        f32x4 acc = {0.f, 0.f, 0.f, 0.f};
        if (st <= tt) {
#pragma unroll
            for (int kk = 0; kk < 4; ++kk) {
                const bf16x8 av = *(const bf16x8*)(qmL + (16 * tt + r) * 136 + 32 * kk + 8 * g);
                const bf16x8 bv = *(const bf16x8*)(kmL + (16 * st + r) * 136 + 32 * kk + 8 * g);
                acc = __builtin_amdgcn_mfma_f32_16x16x32_bf16(av, bv, acc, 0, 0, 0);
            }
        }
#pragma unroll
        for (int i = 0; i < 4; ++i) { const int t = 16 * tt + 4 * g + i, s = 16 * st + r; const float val = (s <= t) ? acc[i] : 0.f;
            AM[t * 64 + s] = (bf16_t)(cvt_pk_bf16(val, 0.f) & 0xffffu); }
    }
    __syncthreads();
}

DI void hgrn_chain(const Args& a, int layer, int bh, unsigned char* lds, int tid, int lane, int wave) {
    const int b = bh >> 2, h = bh & 3, r = lane & 15, g = lane >> 4, w = wave;
    bf16_t* P = (bf16_t*)(a.ws + WS_PROJ);
    float* part = (float*)lds;
    const float nw = a.hon[layer * 512 + h * 128 + 16 * w + r];
    f32x4 S[4][2];
#pragma unroll
    for (int eb = 0; eb < 4; ++eb) { S[eb][0] = (f32x4){0.f, 0.f, 0.f, 0.f}; S[eb][1] = (f32x4){0.f, 0.f, 0.f, 0.f}; }
#pragma unroll 1
    for (int c = 0; c < 32; ++c) {
        const int item = bh * 32 + c, m0 = b * T + c * 64;
        const bf16_t* q1 = (const bf16_t*)(a.ws + WS_Q1) + (size_t)item * 8192; const bf16_t* k2t = (const bf16_t*)(a.ws + WS_K2T) + (size_t)item * 8192;
        const bf16_t* vt = (const bf16_t*)(a.ws + WS_VT) + (size_t)item * 8192; const bf16_t* am = (const bf16_t*)(a.ws + WS_AM) + (size_t)item * 4096;
        const float* dec = (const float*)(a.ws + WS_DEC) + (size_t)item * 128;
        bf16x8 vf[2], sb[4];
#pragma unroll
        for (int ks = 0; ks < 2; ++ks) vf[ks] = *(const bf16x8*)(vt + (16 * w + r) * 64 + 32 * ks + 8 * g);
#pragma unroll
        for (int eb = 0; eb < 4; ++eb) {
            u32x4 t; t.x = cvt_pk_bf16(S[eb][0][0], S[eb][0][1]); t.y = cvt_pk_bf16(S[eb][0][2], S[eb][0][3]); t.z = cvt_pk_bf16(S[eb][1][0], S[eb][1][1]); t.w = cvt_pk_bf16(S[eb][1][2], S[eb][1][3]);
            sb[eb] = __builtin_bit_cast(bf16x8, t);
        }
        f32x4 o[4];
#pragma unroll
        for (int tt = 0; tt < 4; ++tt) {
            o[tt] = (f32x4){0.f, 0.f, 0.f, 0.f};
#pragma unroll
            for (int eb = 0; eb < 4; ++eb) { const bf16x8 av = *(const bf16x8*)(q1 + (16 * tt + r) * 128 + 32 * eb + 8 * g); o[tt] = __builtin_amdgcn_mfma_f32_16x16x32_bf16(av, sb[eb], o[tt], 0, 0, 0); }
#pragma unroll
            for (int ks = 0; ks < 2; ++ks) { const bf16x8 av = *(const bf16x8*)(am + (16 * tt + r) * 64 + 32 * ks + 8 * g); o[tt] = __builtin_amdgcn_mfma_f32_16x16x32_bf16(av, vf[ks], o[tt], 0, 0, 0); }
        }
#pragma unroll
        for (int eb = 0; eb < 4; ++eb)
#pragma unroll
            for (int hh = 0; hh < 2; ++hh) {
                const f32x4 d4 = *(const f32x4*)(dec + 32 * eb + 8 * g + 4 * hh);
                S[eb][hh] = S[eb][hh] * d4;
#pragma unroll
                for (int ks = 0; ks < 2; ++ks) { const bf16x8 av = *(const bf16x8*)(k2t + (32 * eb + 8 * (r >> 2) + 4 * hh + (r & 3)) * 64 + 32 * ks + 8 * g);
                    S[eb][hh] = __builtin_amdgcn_mfma_f32_16x16x32_bf16(av, vf[ks], S[eb][hh], 0, 0, 0); }
            }
        float* pb = part + (c & 1) * 512;
#pragma unroll
        for (int tt = 0; tt < 4; ++tt) {
            f32x4 sq = o[tt] * o[tt];
#pragma unroll
            for (int i = 0; i < 4; ++i) { float v = sq[i]; v += __shfl_xor(v, 1); v += __shfl_xor(v, 2); v += __shfl_xor(v, 4); v += __shfl_xor(v, 8); sq[i] = v; }
            if (r == 0) *(f32x4*)(pb + w * 64 + 16 * tt + 4 * g) = sq;
        }
        __syncthreads();
#pragma unroll
        for (int tt = 0; tt < 4; ++tt) {
            f32x4 tot = {0.f, 0.f, 0.f, 0.f};
#pragma unroll
            for (int ww = 0; ww < 8; ++ww) tot += *(const f32x4*)(pb + ww * 64 + 16 * tt + 4 * g);
#pragma unroll
            for (int i = 0; i < 4; ++i) {
                const int t = 16 * tt + 4 * g + i; const float rs = __builtin_amdgcn_rsqf(tot[i] * (1.0f / 128.f) + EPS);
                bf16_t* rowp = P + (size_t)(m0 + t) * LD;
                const float gate = bf2f(rowp[C_HG + h * 128 + 16 * w + r]);
                const float val = o[tt][i] * rs * nw * fast_sigmoid(gate);
                rowp[C_HQ + h * 128 + 16 * w + r] = (bf16_t)(cvt_pk_bf16(val, 0.f) & 0xffffu);
            }
        }
    }
    __syncthreads();
}

struct AttnState { float m, l; f32x4 O[4]; };
template <int MODE>
DI void attn_seg(bf16_t* P, const float* cb, int mb, int tq, int kcol, int vcol, int kb0, int ks, int jlo, int nt, const bf16x8 (&qf)[2], AttnState& st, unsigned char* vl, int lane) {
    const int r = lane & 15, g = lane >> 4;
#pragma unroll 1
    for (int j = jlo; j < nt; ++j) {
        const int sb0 = 32 * j;
        bf16x8 kf[2][2]; u32x4 vv[4];
#pragma unroll
        for (int h2 = 0; h2 < 2; ++h2) {
            int tk = kb0 + (sb0 + 8 * (r >> 2) + 4 * h2 + (r & 3)) * ks; tk = tk < 0 ? 0 : (tk > T - 1 ? T - 1 : tk);
            const bf16_t* kp = P + (size_t)(mb + tk) * LD + kcol + 8 * g;
            kf[h2][0] = *(const bf16x8*)kp; kf[h2][1] = *(const bf16x8*)(kp + 32);
        }
#pragma unroll
        for (int q4 = 0; q4 < 4; ++q4) {
            int tk = kb0 + (sb0 + 8 * q4 + (lane >> 3)) * ks; tk = tk < 0 ? 0 : (tk > T - 1 ? T - 1 : tk);
            vv[q4] = *(const u32x4*)(P + (size_t)(mb + tk) * LD + vcol + 8 * (lane & 7));
        }
        f32x4 s[2];
#pragma unroll
        for (int h2 = 0; h2 < 2; ++h2) { s[h2] = __builtin_amdgcn_mfma_f32_16x16x32_bf16(kf[h2][0], qf[0], (f32x4){0.f, 0.f, 0.f, 0.f}, 0, 0, 0); s[h2] = __builtin_amdgcn_mfma_f32_16x16x32_bf16(kf[h2][1], qf[1], s[h2], 0, 0, 0); }
        float lg[8]; bool ok[8]; float tmax = -1e30f;
        f32x4 c0 = {0.f, 0.f, 0.f, 0.f}, c1 = {0.f, 0.f, 0.f, 0.f};
        if (MODE == 0) { c0 = *(const f32x4*)(cb + sb0 + 8 * g); c1 = *(const f32x4*)(cb + sb0 + 8 * g + 4); }
#pragma unroll
        for (int idx = 0; idx < 8; ++idx) {
            const int tk = kb0 + (sb0 + 8 * g + idx) * ks;
            float v = s[idx >> 2][idx & 3] * 0.125f;
            if (MODE == 0) { v -= (idx < 4 ? c0[idx & 3] : c1[idx & 3]); ok[idx] = tk <= tq; }
            else ok[idx] = (tk >= 0) && (tk <= tq) && (tq - tk <= 128 * ks);
            lg[idx] = v; tmax = fmaxf(tmax, ok[idx] ? v : -1e30f);
        }
        tmax = fmaxf(tmax, __shfl_xor(tmax, 16)); tmax = fmaxf(tmax, __shfl_xor(tmax, 32));
        const float mnew = fmaxf(st.m, tmax), alpha = __expf(st.m - mnew);
        float p[8], ps = 0.f;
#pragma unroll
        for (int idx = 0; idx < 8; ++idx) { p[idx] = ok[idx] ? __expf(lg[idx] - mnew) : 0.f; ps += p[idx]; }
        st.m = mnew; st.l = st.l * alpha + ps;
        u32x4 pw; pw.x = cvt_pk_bf16(p[0], p[1]); pw.y = cvt_pk_bf16(p[2], p[3]); pw.z = cvt_pk_bf16(p[4], p[5]); pw.w = cvt_pk_bf16(p[6], p[7]);
        const bf16x8 pf = __builtin_bit_cast(bf16x8, pw);
#pragma unroll
        for (int q4 = 0; q4 < 4; ++q4) { unsigned* wp = (unsigned*)(vl + (8 * q4 + (lane >> 3)) * 132 + (lane & 7) * 16); wp[0] = vv[q4].x; wp[1] = vv[q4].y; wp[2] = vv[q4].z; wp[3] = vv[q4].w; }
#pragma unroll
        for (int db = 0; db < 4; ++db) {
            bf16x8 vt;
#pragma unroll
            for (int idx = 0; idx < 8; ++idx) vt[idx] = *(const short*)(vl + (8 * g + idx) * 132 + (16 * db + r) * 2);
            st.O[db] = st.O[db] * alpha;
            st.O[db] = __builtin_amdgcn_mfma_f32_16x16x32_bf16(vt, pf, st.O[db], 0, 0, 0);
        }
    }
}

DI void attn_item(const Args& a, int idx, unsigned char* vl, int lane) {
    bf16_t* P = (bf16_t*)(a.ws + WS_PROJ);
    const int r = lane & 15, g = lane >> 4;
    const bool fox = idx < 4096;
    int bh, q0, qs;
    if (fox) { bh = idx & 31; q0 = 16 * (127 - (idx >> 5)); qs = 1; }
    else { const int i = idx - 4096; bh = i & 31; const int rest = i >> 5; q0 = 256 * (rest >> 4) + (rest & 15); qs = 16; }
    const int b = bh >> 2, h = bh & 3, mb = b * T, tq = q0 + r * qs;
    const int qcol = (fox ? C_FQ : C_DQ) + h * 64;
    bf16x8 qf[2];
    { const bf16_t* qp = P + (size_t)(mb + tq) * LD + qcol + 8 * g; qf[0] = *(const bf16x8*)qp; qf[1] = *(const bf16x8*)(qp + 32); }
    AttnState st; st.m = -1e30f; st.l = 0.f;
#pragma unroll
    for (int db = 0; db < 4; ++db) st.O[db] = (f32x4){0.f, 0.f, 0.f, 0.f};
    if (fox) {
        const float* cb = (const float*)(a.ws + WS_CARR) + (size_t)bh * T;
        attn_seg<0>(P, cb, mb, tq, C_FK + h * 64, C_FV + h * 64, 0, 1, 0, (q0 + 16 + 31) >> 5, qf, st, vl, lane);
    } else {
        const int kcol = C_DK + h * 64, vcol = C_DV + h * 64;
#pragma unroll 1
        for (int br = 0; br < 3; ++br) {
            const int ks = br == 0 ? 1 : (br == 1 ? 4 : 16), nt = br == 0 ? 12 : (br == 1 ? 6 : 5);
            const int kb0 = q0 - 128 * ks;
            const int fv = kb0 >= 0 ? 0 : (-kb0 + ks - 1) / ks;
            attn_seg<1>(P, nullptr, mb, tq, kcol, vcol, kb0, ks, fv >> 5, nt, qf, st, vl, lane);
        }
    }
    float lt = st.l; lt += __shfl_xor(lt, 16); lt += __shfl_xor(lt, 32);
    const float inv = 1.0f / lt;
    bf16_t* op = P + (size_t)(mb + tq) * LD + qcol + 4 * g;
#pragma unroll
    for (int db = 0; db < 4; ++db) { u32x2 w; w.x = cvt_pk_bf16(st.O[db][0] * inv, st.O[db][1] * inv); w.y = cvt_pk_bf16(st.O[db][2] * inv, st.O[db][3] * inv); *(u32x2*)(op + 16 * db) = w; }
}

__global__ void __launch_bounds__(512, 2) fwd_megakernel(Args a) {
    extern __shared__ __attribute__((aligned(16))) unsigned char lds[];
    cg::grid_group grid = cg::this_grid();
    const int tid = threadIdx.x, lane = tid & 63, wave = __builtin_amdgcn_readfirstlane(tid >> 6);
    const int G = gridDim.x;
    float* out = a.out;

    prologue(a, lds, tid, lane, wave);
    grid.sync();

#pragma unroll 1
    for (int op = 0; op < DEPTH * 8; ++op) {
        const int l = op >> 3, k = op & 7;
        int tid = threadIdx.x; asm volatile("" : "+v"(tid));
        const int lane = tid & 63, wave = __builtin_amdgcn_readfirstlane(tid >> 6);
        unsigned char* ws = a.ws; asm volatile("" : "+s"(ws));
        float* out = a.out; bf16_t* xb = (bf16_t*)(ws + WS_XB); float* ssq = (float*)(ws + WS_SSQ); bf16_t* proj = (bf16_t*)(ws + WS_PROJ);
        const unsigned char* wl = ws + WS_W + (size_t)l * W_LAYER;
        if (k == 0 || k == 6) {
            pg8::Gemm g{xb, (const bf16_t*)(wl + (k == 0 ? WO_GU1 : WO_GU2)), M, NGU, D, D, D};
            pg8::StaticOrder S; S.init(M, NGU, G, (int)blockIdx.x);
            EpiSwiGLU E{proj, ssq};
            pg8::gemm_phase<EpiSwiGLU, true>((PG8_LAS unsigned char*)lds, g, S, E, tid);
        } else if (k == 1 || k == 7 || k == 5) {
            const bool isout = (k == 5);
            pg8::Gemm g{proj, (const bf16_t*)(wl + (k == 1 ? WO_D1 : (k == 7 ? WO_D2 : WO_OUT))), M, D, isout ? D : DFF, isout ? LD : DFF, isout ? D : DFF};
            pg8::StaticOrder S; S.init(M, D, G, (int)blockIdx.x);
            EpiResid E{(op == 1) ? a.x : (const float*)out, out, xb, ssq, isout ? 1.0f : 0.5f};
            pg8::gemm_phase<EpiResid, false>((PG8_LAS unsigned char*)lds, g, S, E, tid);
        } else if (k == 2) {
            pg8::Gemm g{xb, (const bf16_t*)(wl + WO_IN), M, LD, D, D, D};
            pg8::StaticOrder S; S.init(M, LD, G, (int)blockIdx.x);
            EpiProj E{proj, ssq, (const float*)(ws + WS_ROPE), (float*)(ws + WS_FFB)};
            pg8::gemm_phase<EpiProj, true>((PG8_LAS unsigned char*)lds, g, S, E, tid);
        } else if (k == 3) {
            if (blockIdx.x < 32) fox_scan(a, l, (int)blockIdx.x, lds, tid, lane, wave);
            for (int it = blockIdx.x; it < 1024; it += G) hgrn_prep(a, l, it, lds, tid, lane, wave);
        } else {
            if (blockIdx.x < 32) hgrn_chain(a, l, (int)blockIdx.x, lds, tid, lane, wave);
            unsigned* ctr = (unsigned*)(ws + WS_CTL) + 64 * l;
            unsigned char* vl = lds + 8192 + wave * 4352;
            for (;;) {
                unsigned it = 0;
                if (lane == 0) it = atomicAdd(ctr, 1u);
                it = __builtin_amdgcn_readfirstlane(it);
                if (it >= 8192u) break;
                attn_item(a, (int)it, vl, lane);
            }
        }
        grid.sync();
    }
    {
        int tid2 = threadIdx.x; asm volatile("" : "+v"(tid2));
        const int lane = tid2 & 63, wave = __builtin_amdgcn_readfirstlane(tid2 >> 6);
        const int gw = blockIdx.x * 8 + wave, NGW = G * 8;
        for (int m = gw; m < M; m += NGW) {
            f32x4* xr = (f32x4*)(out + (size_t)m * D) + lane; f32x4 v[4]; float s = 0.f;
#pragma unroll
            for (int j = 0; j < 4; ++j) { v[j] = xr[64 * j]; s += (v[j][0] * v[j][0] + v[j][1] * v[j][1]) + (v[j][2] * v[j][2] + v[j][3] * v[j][3]); }
#pragma unroll
            for (int o = 1; o < 64; o <<= 1) s += __shfl_xor(s, o);
            const float rs = 1.0f / sqrtf(s * (1.0f / D) + EPS);
#pragma unroll
            for (int j = 0; j < 4; ++j) { const f32x4 gn = ((const f32x4*)a.fn)[lane + 64 * j]; xr[64 * j] = v[j] * rs * gn; }
        }
    }
}

extern "C" void kernel_launch(void* const* d_in, const int* in_sizes, int n_in, void* d_out, int out_size, void* d_ws, size_t ws_size, hipStream_t stream) {
    static int grid = 0;
    if (grid == 0) {
        if (n_in != 17 || out_size != M * D || ws_size < WS_END) { fprintf(stderr, "kernel_launch: unexpected shapes / workspace (n_in %d out %d ws %zu)\n", n_in, out_size, ws_size); grid = -1; return; }
        int dev = 0, cus = 0, per_cu = 0;
        (void)hipGetDevice(&dev);
        (void)hipDeviceGetAttribute(&cus, hipDeviceAttributeMultiprocessorCount, dev);
        (void)hipFuncSetAttribute((const void*)fwd_megakernel, hipFuncAttributeMaxDynamicSharedMemorySize, LDS_BYTES);
        (void)hipOccupancyMaxActiveBlocksPerMultiprocessor(&per_cu, (const void*)fwd_megakernel, 512, LDS_BYTES);
        (void)hipGetLastError();
        if (per_cu < 1) per_cu = 1;
        grid = cus * per_cu;
    }
    if (grid < 0) return;
    (void)hipMemsetAsync((char*)d_ws + WS_CTL, 0, 4096, stream);
    Args a{};
    a.x = (const float*)d_in[0]; a.pos = (const int*)d_in[1];
    a.f1n = (const float*)d_in[2]; a.f1g = (const float*)d_in[3]; a.f1u = (const float*)d_in[4]; a.f1d = (const float*)d_in[5];
    a.mn = (const float*)d_in[6]; a.win = (const float*)d_in[7]; a.fb = (const float*)d_in[8]; a.hlb = (const float*)d_in[9]; a.hon = (const float*)d_in[10];
    a.wout = (const float*)d_in[11]; a.f2n = (const float*)d_in[12]; a.f2g = (const float*)d_in[13]; a.f2u = (const float*)d_in[14]; a.f2d = (const float*)d_in[15];
    a.fn = (const float*)d_in[16];
    a.out = (float*)d_out; a.ws = (unsigned char*)d_ws;
    void* args[] = {&a};
    hipError_t e = hipLaunchCooperativeKernel((const void*)fwd_megakernel, dim3(grid), dim3(512), args, LDS_BYTES, stream);
    if (e != hipSuccess) fprintf(stderr, "cooperative launch failed: %s (grid %d)\n", hipGetErrorString(e), grid);
}
```

```cpp
#include <hip/hip_runtime.h>
#include <hip/hip_cooperative_groups.h>
#include <cstdio>
#include <cstdint>
namespace cg = cooperative_groups;

#define DI __device__ __forceinline__
typedef unsigned short bf16_t;
typedef short bf16x8 __attribute__((ext_vector_type(8)));
typedef float f32x4 __attribute__((ext_vector_type(4)));
typedef unsigned u32x4 __attribute__((ext_vector_type(4)));
typedef unsigned u32x2 __attribute__((ext_vector_type(2)));

constexpr int BATCH = 8, T = 2048, D = 1024, DEPTH = 4, M = BATCH * T, DFF = 2816, NIN = 3588, LD = 3840;
constexpr int NGU = 2 * DFF;
constexpr int C_FQ = 0, C_DQ = 256, C_HQ = 512, C_FK = 1024, C_FV = 1280, C_DK = 1536, C_DV = 1792, C_HF = 2048, C_HI = 2560, C_HG = 3072, C_FF = 3584;
constexpr int S_FQ = 0, S_FK = 256, S_FV = 512, S_FF = 768, S_DQ = 772, S_DK = 1028, S_DV = 1284, S_HQ = 1540, S_HF = 2052, S_HI = 2564, S_HG = 3076;
constexpr float EPS = 1e-6f;

constexpr size_t MiB = 1u << 20;
constexpr size_t WS_CTL = 0, WS_SSQ = 1 * MiB, WS_ROPE = 2 * MiB, WS_FFB = 3 * MiB, WS_CARR = 3 * MiB + 256 * 1024, WS_LBS = 3 * MiB + 512 * 1024, WS_DEC = 4 * MiB;
constexpr size_t WS_W = 6 * MiB, W_LAYER = 42 * MiB + 512 * 1024;
constexpr size_t WO_GU1 = 0, WO_D1 = 11 * MiB, WO_IN = 16 * MiB + 512 * 1024, WO_OUT = 24 * MiB, WO_GU2 = 26 * MiB, WO_D2 = 37 * MiB;
constexpr size_t WS_XB = 176 * MiB, WS_PROJ = 208 * MiB, WS_Q1 = 328 * MiB, WS_K2T = 344 * MiB, WS_VT = 360 * MiB, WS_AM = 376 * MiB, WS_END = 384 * MiB;
static_assert(WS_W + 4 * W_LAYER <= WS_XB && WS_XB + (size_t)M * D * 2 <= WS_PROJ && WS_PROJ + (size_t)M * LD * 2 <= WS_Q1, "ws map");

constexpr int LDS_BYTES = 147456;
#ifndef ATT_TR
#define ATT_TR 1
#endif

DI float bf2f(unsigned short h) { return __uint_as_float(((unsigned)h) << 16); }
DI unsigned cvt_pk_bf16(float lo, float hi) { unsigned r; asm("v_cvt_pk_bf16_f32 %0, %1, %2" : "=v"(r) : "v"(lo), "v"(hi)); return r; }
template <int CTRL> DI float dpp_add(float v) { return v + __int_as_float(__builtin_amdgcn_update_dpp(0, __float_as_int(v), CTRL, 0xf, 0xf, false)); }
DI float row16_sum(float v) {
    v = dpp_add<0xB1>(v); v = dpp_add<0x4E>(v); v = dpp_add<0x141>(v); v = dpp_add<0x140>(v); return v;
}
DI float shfl_lane(float v, int src_lane) { return __int_as_float(__builtin_amdgcn_ds_bpermute(src_lane << 2, __float_as_int(v))); }
DI float fast_sigmoid(float x) { return __builtin_amdgcn_rcpf(1.f + __expf(-x)); }

namespace pg8 {
#define PG8_LAS __attribute__((address_space(3)))
constexpr int BM = 256, BK = 64, HALF = 128, HTB = HALF * BK * 2, STAGE_BYTES = 8 * HTB, NXCD = 8, WGM = 8;
__host__ __device__ __forceinline__ int lds_byte(int r, int c) { const int st = (r >> 4) * 2 + (c >> 5), rr = r & 15, cc = c & 31, ob = rr * 64 + cc * 2; return st * 1024 + (ob ^ (((ob >> 9) & 1) << 5)); }
__host__ __device__ __forceinline__ void stage_rc(int b, int& R, int& C) { const int st = b / 1024, sb = b % 1024, swz = sb ^ (((sb >> 9) & 1) << 5); R = (st >> 1) * 16 + swz / 64; C = (st & 1) * 32 + (swz % 64) / 2; }
__host__ __device__ __forceinline__ int perm32(int rho) { const int n = rho >> 4, i = rho & 15; return 8 * (i >> 2) + 4 * n + (i & 3); }

struct Unit { int pm, pn; };
struct Gemm { const bf16_t* A; const bf16_t* Bt; int M, N, K, lda, ldb; };

struct StaticOrder {
    int nM, nN, nwg, G, c;
    __host__ __device__ void init(int M_, int N_, int G_, int c_) { nM = M_ / BM; nN = N_ / BM; nwg = nM * nN; G = G_; c = c_; }
    __host__ __device__ bool next(int i, Unit& u) const {
        const long L = (long)i * G + c; if (L >= nwg) return false;
        int wgid = (int)L; { const int q = nwg / NXCD, r = nwg % NXCD, xcd = wgid % NXCD, off = wgid / NXCD; wgid = (xcd < r ? xcd * (q + 1) : r * (q + 1) + (xcd - r) * q) + off; }
        const int nig = WGM * nN, gid = wgid / nig, fm = gid * WGM, gsz = (nM - fm) < WGM ? (nM - fm) : WGM;
        u.pm = fm + ((wgid % nig) % gsz); u.pn = (wgid % nig) / gsz; return true;
    }
};

template <class Epi, bool ALIGN_EPI>
__device__ __forceinline__ void gemm_phase(PG8_LAS unsigned char* lds, const Gemm g, const StaticOrder& S, const Epi& E, const int tid) {
    const int wid = __builtin_amdgcn_readfirstlane(tid >> 6), lane = tid & 63, wr = wid >> 2, wc = wid & 3, fr = lane & 15, fq = lane >> 4;
    const int K = g.K, nt = K / BK;
    unsigned voffA[2], voffB[2];
#pragma unroll
    for (int i = 0; i < 2; ++i) { int R, C; stage_rc(tid * 16 + i * 8192, R, C); const int Rb = (R & ~31) + perm32(R & 31);
        voffA[i] = (unsigned)(R * g.lda + C) * 2u; voffB[i] = (unsigned)(Rb * g.ldb + C) * 2u; }
    const size_t kstep = (size_t)(BK * 2);
    const size_t hA = (size_t)HALF * g.lda * 2, hB = (size_t)HALF * g.ldb * 2, tA = 2 * hA, tB = 2 * hB;
    const unsigned ldsw = (unsigned)wid * 1024u;
    const int aoff = lds_byte(wr * 64 + fr, fq * 8), boff = lds_byte(wc * 32 + fr, fq * 8);
#define PG8_SA(b, h) (((b) * 2 + (h)) * HTB)
#define PG8_SB(b, h) ((4 + (b) * 2 + (h)) * HTB)
#define PG8_STAGE(bufoff, gbase, voff) do { _Pragma("unroll") for (int _i = 0; _i < 2; ++_i) \
        __builtin_amdgcn_global_load_lds((const unsigned*)((const char*)(gbase) + (voff)[_i]), (PG8_LAS unsigned*)(lds + (bufoff) + ldsw + _i * 8192), 16, 0, 0); } while (0)
#define PG8_LDA(dst, b, h) do { _Pragma("unroll") for (int m = 0; m < 4; ++m) _Pragma("unroll") for (int k = 0; k < 2; ++k) dst[m][k] = *(const PG8_LAS bf16x8*)(lds + PG8_SA(b, h) + aoff + m * 2048 + k * 1024); } while (0)
#define PG8_LDB(dst, b, h) do { _Pragma("unroll") for (int n = 0; n < 2; ++n) _Pragma("unroll") for (int k = 0; k < 2; ++k) dst[n][k] = *(const PG8_LAS bf16x8*)(lds + PG8_SB(b, h) + boff + n * 2048 + k * 1024); } while (0)
#define PG8_MMA(ai, bj, At, Bt) do { __builtin_amdgcn_s_setprio(1); _Pragma("unroll") for (int m = 0; m < 4; ++m) _Pragma("unroll") for (int n = 0; n < 2; ++n) _Pragma("unroll") for (int k = 0; k < 2; ++k) \
        acc[ai][bj][m][n] = __builtin_amdgcn_mfma_f32_16x16x32_bf16(Bt[n][k], At[m][k], acc[ai][bj][m][n], 0, 0, 0); __builtin_amdgcn_s_setprio(0); } while (0)
#define PG8_WAIT_V(n) asm volatile("s_waitcnt vmcnt(" #n ")" ::: "memory")
#define PG8_WAIT_L(n) asm volatile("s_waitcnt lgkmcnt(" #n ")" ::: "memory")
#define PG8_BAR __builtin_amdgcn_s_barrier()
#define PG8_SCHED __builtin_amdgcn_sched_barrier(0)
    Unit cur, nxt; int ui = 0;
    if (!S.next(0, cur)) return;
    f32x4 acc[2][2][4][2];
#pragma unroll
    for (int a = 0; a < 2; ++a)
#pragma unroll
        for (int b = 0; b < 2; ++b)
#pragma unroll
            for (int m = 0; m < 4; ++m)
#pragma unroll
                for (int n = 0; n < 2; ++n) acc[a][b][m][n] = (f32x4){0.f, 0.f, 0.f, 0.f};
    bf16x8 At[4][2], B0[2][2], B1[2][2];
    const char* cA = (const char*)g.A + (size_t)cur.pm * tA; const char* cB = (const char*)g.Bt + (size_t)cur.pn * tB;
    PG8_STAGE(PG8_SB(0, 0), cB, voffB); PG8_STAGE(PG8_SB(0, 1), cB + hB, voffB); PG8_STAGE(PG8_SA(0, 0), cA, voffA); PG8_STAGE(PG8_SA(0, 1), cA + hA, voffA);
    if (wr == 1) PG8_BAR;
    PG8_WAIT_V(2); PG8_BAR;
    PG8_STAGE(PG8_SB(1, 0), cB + kstep, voffB); PG8_STAGE(PG8_SA(1, 0), cA + kstep, voffA); PG8_STAGE(PG8_SB(1, 1), cB + hB + kstep, voffB);
    PG8_WAIT_V(6); PG8_BAR;
    for (;;) {
        const bool has_next = S.next(ui + 1, nxt);
        const char* nA = has_next ? (const char*)g.A + (size_t)nxt.pm * tA : cA; const char* nB = has_next ? (const char*)g.Bt + (size_t)nxt.pn * tB : cB;
        for (int t = 0; t < nt; t += 2) {
            const bool last = (t == nt - 2);
            const char* a1 = cA + (size_t)(t + 1) * kstep;
            const char* a2 = last ? nA : cA + (size_t)(t + 2) * kstep; const char* b2 = last ? nB : cB + (size_t)(t + 2) * kstep;
            const char* a3 = a2 + kstep; const char* b3 = b2 + kstep;
            PG8_LDB(B0, 0, 0); PG8_LDB(B1, 0, 1); PG8_SCHED; PG8_LDA(At, 0, 0); PG8_STAGE(PG8_SA(1, 1), a1 + hA, voffA);
            PG8_WAIT_V(8); PG8_WAIT_L(0); PG8_BAR; PG8_MMA(0, 0, At, B0); PG8_MMA(0, 1, At, B1); PG8_BAR; PG8_SCHED;
            PG8_LDA(At, 0, 1); PG8_STAGE(PG8_SB(0, 0), b2, voffB); PG8_STAGE(PG8_SB(0, 1), b2 + hB, voffB); PG8_STAGE(PG8_SA(0, 0), a2, voffA);
            PG8_WAIT_V(8); PG8_WAIT_L(0); PG8_BAR; PG8_MMA(1, 0, At, B0); PG8_MMA(1, 1, At, B1); PG8_BAR; PG8_SCHED;
            PG8_LDB(B0, 1, 0); PG8_LDB(B1, 1, 1); PG8_SCHED; PG8_LDA(At, 1, 0); PG8_STAGE(PG8_SA(0, 1), a2 + hA, voffA);
            PG8_WAIT_V(8); PG8_WAIT_L(0); PG8_BAR; PG8_MMA(0, 0, At, B0); PG8_MMA(0, 1, At, B1); PG8_BAR; PG8_SCHED;
            PG8_LDA(At, 1, 1); PG8_STAGE(PG8_SB(1, 0), b3, voffB); PG8_STAGE(PG8_SB(1, 1), b3 + hB, voffB); PG8_STAGE(PG8_SA(1, 0), a3, voffA);
            PG8_WAIT_V(8); PG8_WAIT_L(0); PG8_BAR; PG8_MMA(1, 0, At, B0); PG8_MMA(1, 1, At, B1); PG8_BAR; PG8_SCHED;
        }
        if constexpr (ALIGN_EPI) { if (wr == 0) PG8_BAR; }
        E(acc, cur, wr, wc, fr, fq);
        if (!has_next) break;
#pragma unroll
        for (int a = 0; a < 2; ++a)
#pragma unroll
            for (int b = 0; b < 2; ++b)
#pragma unroll
                for (int m = 0; m < 4; ++m)
#pragma unroll
                    for (int n = 0; n < 2; ++n) acc[a][b][m][n] = (f32x4){0.f, 0.f, 0.f, 0.f};
        cur = nxt; cA = nA; cB = nB; ++ui;
        if constexpr (ALIGN_EPI) { if (wr == 1) PG8_BAR; }
    }
    PG8_WAIT_V(0);
    if constexpr (!ALIGN_EPI) { if (wr == 0) PG8_BAR; }
    PG8_BAR;
#undef PG8_SA
#undef PG8_SB
#undef PG8_STAGE
#undef PG8_LDA
#undef PG8_LDB
#undef PG8_MMA
#undef PG8_WAIT_V
#undef PG8_WAIT_L
#undef PG8_BAR
#undef PG8_SCHED
}
}

DI float row_rs(const float* ssq, int row) {
    const f32x4* p = (const f32x4*)(ssq + (size_t)row * 16);
    const f32x4 a = p[0], b = p[1], c = p[2], d = p[3];
    const float s = ((a[0] + a[1]) + (a[2] + a[3])) + ((b[0] + b[1]) + (b[2] + b[3])) + ((c[0] + c[1]) + (c[2] + c[3])) + ((d[0] + d[1]) + (d[2] + d[3]));
    return __builtin_amdgcn_rsqf(s * (1.0f / D) + EPS);
}

DI void rows_rs8(const float* ssq, int row0, int fr, int fq, float (&rs)[2][4]) {
    const int lane = fr + 16 * fq;
#pragma unroll
    for (int ai = 0; ai < 2; ++ai) {
        f32x4 p[4];
#pragma unroll
        for (int m = 0; m < 4; ++m) p[m] = *(const f32x4*)(ssq + (size_t)(row0 + ai * 128 + m * 16) * 16 + 4 * fq);
#pragma unroll
        for (int m = 0; m < 4; ++m) { float s = (p[m][0] + p[m][1]) + (p[m][2] + p[m][3]); s += shfl_lane(s, lane ^ 16); s += shfl_lane(s, lane ^ 32); rs[ai][m] = __builtin_amdgcn_rsqf(s * (1.0f / D) + EPS); }
        asm volatile("" ::: "memory");
    }
}

struct EpiSwiGLU {
    bf16_t* H; const float* ssq;
    DI void operator()(const f32x4 (&acc)[2][2][4][2], const pg8::Unit& u, int wr, int wc, int fr, int fq) const {
        const int row0 = u.pm * 256 + wr * 64 + fr, col = u.pn * 128 + wc * 32 + 8 * fq;
        float rs8[2][4]; rows_rs8(ssq, u.pm * 256 + wr * 64 + fr, fr, fq, rs8);
#pragma unroll
        for (int ai = 0; ai < 2; ++ai)
#pragma unroll
            for (int m = 0; m < 4; ++m) {
                const int row = row0 + ai * 128 + m * 16; const float r = rs8[ai][m];
                float hv[8];
#pragma unroll
                for (int n = 0; n < 2; ++n)
#pragma unroll
                    for (int i = 0; i < 4; ++i) { const float gg = acc[ai][0][m][n][i] * r, uu = acc[ai][1][m][n][i] * r; hv[n * 4 + i] = gg * fast_sigmoid(gg) * uu; }
                u32x4 w; w.x = cvt_pk_bf16(hv[0], hv[1]); w.y = cvt_pk_bf16(hv[2], hv[3]); w.z = cvt_pk_bf16(hv[4], hv[5]); w.w = cvt_pk_bf16(hv[6], hv[7]);
                *(u32x4*)(H + (size_t)row * DFF + col) = w;
                asm volatile("" ::: "memory");
            }
    }
};

struct EpiResid {
    bf16_t* xb; float* ssq; float alpha;
    DI void operator()(const f32x4 (&acc)[2][2][4][2], const pg8::Unit& u, int wr, int wc, int fr, int fq) const {
        const int row0 = u.pm * 256 + wr * 64 + fr, col0 = u.pn * 256 + wc * 32 + 8 * fq;
#pragma unroll
        for (int ai = 0; ai < 2; ++ai) {
            u32x4 xw[4][2];
#pragma unroll
            for (int m = 0; m < 4; ++m)
#pragma unroll
                for (int bj = 0; bj < 2; ++bj) xw[m][bj] = *(const u32x4*)(xb + (size_t)(row0 + ai * 128 + m * 16) * D + col0 + bj * 128);
#pragma unroll
            for (int m = 0; m < 4; ++m) {
                const int row = row0 + ai * 128 + m * 16; float ss = 0.f;
#pragma unroll
                for (int bj = 0; bj < 2; ++bj) {
                    const size_t off = (size_t)row * D + col0 + bj * 128;
                    float y[8];
#pragma unroll
                    for (int q = 0; q < 4; ++q) { const unsigned wv = xw[m][bj][q]; y[2 * q] = __uint_as_float(wv << 16); y[2 * q + 1] = __uint_as_float(wv & 0xffff0000u); }
#pragma unroll
                    for (int q = 0; q < 4; ++q) { y[q] += acc[ai][bj][m][0][q] * alpha; y[4 + q] += acc[ai][bj][m][1][q] * alpha; }
                    u32x4 w; w.x = cvt_pk_bf16(y[0], y[1]); w.y = cvt_pk_bf16(y[2], y[3]); w.z = cvt_pk_bf16(y[4], y[5]); w.w = cvt_pk_bf16(y[6], y[7]);
                    *(u32x4*)(xb + off) = w;
#pragma unroll
                    for (int q = 0; q < 4; ++q) { const float a0 = __uint_as_float(w[q] << 16), a1 = __uint_as_float(w[q] & 0xffff0000u); ss += a0 * a0 + a1 * a1; }
                }
                { const int ln = fr + 16 * fq; ss += shfl_lane(ss, ln ^ 16); ss += shfl_lane(ss, ln ^ 32); }
                if (fq == 0) ssq[(size_t)row * 16 + u.pn * 4 + wc] = ss;
            }
            asm volatile("" ::: "memory");
        }
    }
};

struct EpiProj {
    bf16_t* P; const float* ssq; const float* rope; float* ffb;
    DI void operator()(const f32x4 (&acc)[2][2][4][2], const pg8::Unit& u, int wr, int wc, int fr, int fq) const {
        const int row0 = u.pm * 256 + wr * 64 + fr, colw = wc * 32 + 8 * fq;
        const bool rot = (u.pn == 1 || u.pn == 6) && ((colw & 63) < 16);
        const int ra = ((colw & 63) == 0) ? 0 : 4;
        float rs8[2][4]; rows_rs8(ssq, u.pm * 256 + wr * 64 + fr, fr, fq, rs8);
#pragma unroll
        for (int ai = 0; ai < 2; ++ai)
#pragma unroll
            for (int m = 0; m < 4; ++m) {
                const int row = row0 + ai * 128 + m * 16; const float r = rs8[ai][m];
                if (u.pn == 14) { if (wc == 0 && fq == 0) *(f32x4*)(ffb + (size_t)row * 4) = acc[ai][0][m][0] * r; continue; }
                f32x4 cs = {1.f, 1.f, 1.f, 1.f}, sn = {0.f, 0.f, 0.f, 0.f};
                if (rot) { cs = *(const f32x4*)(rope + (size_t)row * 16 + ra); sn = *(const f32x4*)(rope + (size_t)row * 16 + 8 + ra); }
#pragma unroll
                for (int bj = 0; bj < 2; ++bj) {
                    const f32x4 v0 = acc[ai][bj][m][0] * r, v1 = acc[ai][bj][m][1] * r;
                    const f32x4 o0 = v0 * cs - v1 * sn, o1 = v1 * cs + v0 * sn;
                    u32x4 w; w.x = cvt_pk_bf16(o0[0], o0[1]); w.y = cvt_pk_bf16(o0[2], o0[3]); w.z = cvt_pk_bf16(o1[0], o1[1]); w.w = cvt_pk_bf16(o1[2], o1[3]);
                    *(u32x4*)(P + (size_t)row * LD + u.pn * 256 + bj * 128 + colw) = w;
                }
                asm volatile("" ::: "memory");
            }
    }
};

DI int rope_perm(int j) { return (j >= 4 && j < 8) ? j + 4 : ((j >= 8 && j < 12) ? j - 4 : j); }
DI int win_src(int d) {
    if (d < 256) return S_FQ + d;
    if (d < 512) { const int j = d - 256; return S_DQ + (j & ~63) + rope_perm(j & 63); }
    if (d < 1024) return S_HQ + (d - 512);
    if (d < 1280) return S_FK + (d - 1024);
    if (d < 1536) return S_FV + (d - 1280);
    if (d < 1792) { const int j = d - 1536; return S_DK + (j & ~63) + rope_perm(j & 63); }
    if (d < 2048) return S_DV + (d - 1792);
    if (d < 2560) return S_HF + (d - 2048);
    if (d < 3072) return S_HI + (d - 2560);
    if (d < 3584) return S_HG + (d - 3072);
    if (d < 3588) return S_FF + (d - 3584);
    return -1;
}
DI void conv_item(const float* W, int N, int K, const float* gk, bf16_t* WT, int drow0, int mode, int src0, int kb, float* scr, int lane) {
    const int k0 = 64 * kb, n4 = (lane & 7) * 4;
    const int sc = mode == 0 ? src0 + n4 : win_src(drow0 + n4);
    f32x4 v[8];
    const float* wp = W + (size_t)(k0 + (lane >> 3)) * N + (sc >= 0 ? sc : 0);
#pragma unroll
    for (int i = 0; i < 8; ++i) v[i] = *(const f32x4*)(wp + (size_t)(8 * i) * N);
#pragma unroll
    for (int i = 0; i < 8; ++i) { float* sp = scr + (8 * i + (lane >> 3)) * 33 + n4;
        sp[0] = (sc >= 0) ? v[i][0] : 0.f; sp[1] = (sc >= 0) ? v[i][1] : 0.f; sp[2] = (sc >= 0) ? v[i][2] : 0.f; sp[3] = (sc >= 0) ? v[i][3] : 0.f; }
    asm volatile("s_waitcnt lgkmcnt(0)" ::: "memory");
    const int c = lane & 7;
    f32x4 g0 = {1.f, 1.f, 1.f, 1.f}, g1 = {1.f, 1.f, 1.f, 1.f};
    if (gk) { g0 = *(const f32x4*)(gk + k0 + 8 * c); g1 = *(const f32x4*)(gk + k0 + 8 * c + 4); }
#pragma unroll
    for (int j = 0; j < 4; ++j) { const int nn = (lane >> 3) + 8 * j; const float* s = scr + (8 * c) * 33 + nn;
        u32x4 o; o.x = cvt_pk_bf16(s[0 * 33] * g0[0], s[1 * 33] * g0[1]); o.y = cvt_pk_bf16(s[2 * 33] * g0[2], s[3 * 33] * g0[3]); o.z = cvt_pk_bf16(s[4 * 33] * g1[0], s[5 * 33] * g1[1]); o.w = cvt_pk_bf16(s[6 * 33] * g1[2], s[7 * 33] * g1[3]);
        *(u32x4*)(WT + (size_t)(drow0 + nn) * K + k0 + 8 * c) = o; }
    asm volatile("s_waitcnt lgkmcnt(0)" ::: "memory");
}

struct Args {
    const float* x; const int* pos;
    const float *f1n, *f1g, *f1u, *f1d, *mn, *win, *fb, *hlb, *hon, *wout, *f2n, *f2g, *f2u, *f2d, *fn;
    float* out; unsigned char* ws;
};

DI void sincos_d(double x, float& s, float& c) {
    const double k = __builtin_rint(x * 0.63661977236758134308);
    const double r = (x - k * 1.5707963267948966192) - k * 6.123233995736766e-17;
    const double r2 = r * r;
    double sp = r * (1.0 + r2 * (-1.0 / 6 + r2 * (1.0 / 120 + r2 * (-1.0 / 5040 + r2 * (1.0 / 362880 + r2 * (-1.0 / 39916800))))));
    double cp = 1.0 + r2 * (-0.5 + r2 * (1.0 / 24 + r2 * (-1.0 / 720 + r2 * (1.0 / 40320 + r2 * (-1.0 / 3628800 + r2 * (1.0 / 479001600))))));
    const int q = ((int)k) & 3;
    const double ss = (q == 0) ? sp : (q == 1) ? cp : (q == 2) ? -sp : -cp;
    const double cc = (q == 0) ? cp : (q == 1) ? -sp : (q == 2) ? -cp : sp;
    s = (float)ss; c = (float)cc;
}

DI void prologue(const Args& a, unsigned char* lds, int tid, int lane, int wave) {
    unsigned char* ws = a.ws;
    const int gw = blockIdx.x * 8 + wave, NGW = gridDim.x * 8;
    float* scr = (float*)(lds + wave * 16384);
    constexpr int I_GU = 16 * (NGU / 32), I_D = (DFF / 64) * (D / 32), I_IN = 16 * (LD / 32), I_OUT = 16 * (D / 32);
    constexpr int I_LAYER = 2 * I_GU + 2 * I_D + I_IN + I_OUT;
    for (int it = gw; it < DEPTH * I_LAYER; it += NGW) {
        const int l = it / I_LAYER; int r = it % I_LAYER;
        unsigned char* wl = ws + WS_W + (size_t)l * W_LAYER;
        if (r < 2 * I_GU) {
            const int f = r >= I_GU; if (f) r -= I_GU;
            const int rb = r >> 4, kb = r & 15, d0 = rb * 32, pn = d0 >> 8, within = d0 & 255;
            const float* Wg = (f ? a.f2g : a.f1g) + (size_t)l * D * DFF; const float* Wu = (f ? a.f2u : a.f1u) + (size_t)l * D * DFF;
            const float* gk = (f ? a.f2n : a.f1n) + (size_t)l * D;
            conv_item(within < 128 ? Wg : Wu, DFF, D, gk, (bf16_t*)(wl + (f ? WO_GU2 : WO_GU1)), d0, 0, 128 * pn + (within & 127), kb, scr, lane);
            continue;
        }
        r -= 2 * I_GU;
        if (r < 2 * I_D) {
            const int f = r >= I_D; if (f) r -= I_D;
            const int rb = r / (DFF / 64), kb = r % (DFF / 64);
            conv_item((f ? a.f2d : a.f1d) + (size_t)l * DFF * D, D, DFF, nullptr, (bf16_t*)(wl + (f ? WO_D2 : WO_D1)), rb * 32, 0, rb * 32, kb, scr, lane);
            continue;
        }
        r -= 2 * I_D;
        if (r < I_IN) { const int rb = r >> 4, kb = r & 15;
            conv_item(a.win + (size_t)l * D * NIN, NIN, D, a.mn + (size_t)l * D, (bf16_t*)(wl + WO_IN), rb * 32, 1, 0, kb, scr, lane); continue; }
        r -= I_IN;
        { const int rb = r >> 4, kb = r & 15; conv_item(a.wout + (size_t)l * D * D, D, D, nullptr, (bf16_t*)(wl + WO_OUT), rb * 32, 0, rb * 32, kb, scr, lane); }
    }
    bf16_t* xb = (bf16_t*)(ws + WS_XB); float* ssq = (float*)(ws + WS_SSQ);
    for (int m = gw; m < M; m += NGW) {
        const f32x4* xr = (const f32x4*)(a.x + (size_t)m * D) + lane; float s = 0.f;
        u32x2* o8 = (u32x2*)(xb + (size_t)m * D) + lane;
#pragma unroll
        for (int j = 0; j < 4; ++j) { const f32x4 v = xr[64 * j]; u32x2 w; w.x = cvt_pk_bf16(v[0], v[1]); w.y = cvt_pk_bf16(v[2], v[3]); o8[64 * j] = w;
            const float a0 = __uint_as_float(w.x << 16), a1 = __uint_as_float(w.x & 0xffff0000u), a2 = __uint_as_float(w.y << 16), a3 = __uint_as_float(w.y & 0xffff0000u); s += (a0 * a0 + a1 * a1) + (a2 * a2 + a3 * a3); }
#pragma unroll
        for (int o = 1; o < 64; o <<= 1) s += __shfl_xor(s, o);
        if (lane < 16) ssq[(size_t)m * 16 + lane] = lane == 0 ? s : 0.f;
    }
    float* rope = (float*)(ws + WS_ROPE);
    for (int i = blockIdx.x * 512 + tid; i < M * 8; i += gridDim.x * 512) {
        const int m = i >> 3, fi = i & 7;
        const float freq = exp2f(-(float)fi * 0.125f * 18.931568569324174f);
        const float ang = (float)a.pos[m] * freq;
        float s, c; sincos_d((double)ang, s, c);
        rope[(size_t)m * 16 + fi] = c; rope[(size_t)m * 16 + 8 + fi] = s;
    }
    if (blockIdx.x == 0) {
        float* lbs = (float*)(ws + WS_LBS); const int j = tid;
        float v[DEPTH], mx = -1e30f, sum = 0.f;
#pragma unroll
        for (int l = 0; l < DEPTH; ++l) { v[l] = a.hlb[l * 512 + j]; mx = fmaxf(mx, v[l]); }
#pragma unroll
        for (int l = 0; l < DEPTH; ++l) { v[l] = expf(v[l] - mx); sum += v[l]; }
        float run = 0.f;
#pragma unroll
        for (int l = 0; l < DEPTH; ++l) { if (l > 0) run += v[l] / sum; lbs[l * 512 + j] = fminf(fmaxf(run, 0.f), 1.0f - 1e-6f); }
    }
}

DI float log_sigmoid(float z) { return fminf(z, 0.f) - __logf(1.f + __expf(-fabsf(z))); }

DI void fox_scan(const Args& a, int layer, int bh, unsigned char* lds, int tid, int lane, int wave) {
    const int b = bh >> 2, h = bh & 3;
    const float* ffb = (const float*)(a.ws + WS_FFB); float* carr = (float*)(a.ws + WS_CARR) + (size_t)bh * T;
    const float bias = a.fb[layer * 4 + h];
    float v[4], run = 0.f;
#pragma unroll
    for (int j = 0; j < 4; ++j) { const int t = tid * 4 + j; run += log_sigmoid(ffb[(size_t)(b * T + t) * 4 + h] + bias); v[j] = run; }
    float inc = run;
#pragma unroll
    for (int o = 1; o < 64; o <<= 1) { const float up = shfl_lane(inc, (lane - o) & 63); if (lane >= o) inc += up; }
    float* wt = (float*)lds;
    if (lane == 63) wt[wave] = inc;
    __syncthreads();
    float pre = inc - run;
    for (int w = 0; w < wave; ++w) pre += wt[w];
    f32x4 o = {v[0] + pre, v[1] + pre, v[2] + pre, v[3] + pre};
    *(f32x4*)(carr + tid * 4) = o;
    __syncthreads();
}

DI void hgrn_prep(const Args& a, int layer, int item, unsigned char* lds, int tid, int lane, int wave) {
    const int bh = item >> 5, c = item & 31, b = bh >> 2, h = bh & 3, m0 = b * T + c * 64;
    const bf16_t* P = (const bf16_t*)(a.ws + WS_PROJ) + (size_t)m0 * LD;
    bf16_t* Q1 = (bf16_t*)(a.ws + WS_Q1) + (size_t)item * 8192; bf16_t* K2T = (bf16_t*)(a.ws + WS_K2T) + (size_t)item * 8192;
    bf16_t* VT = (bf16_t*)(a.ws + WS_VT) + (size_t)item * 8192; bf16_t* AM = (bf16_t*)(a.ws + WS_AM) + (size_t)item * 4096;
    float* DEC = (float*)(a.ws + WS_DEC) + (size_t)item * 128;
    bf16_t* qmL = (bf16_t*)lds; bf16_t* kmL = (bf16_t*)(lds + 17408); float* tot = (float*)(lds + 34816);
    bf16_t* zL = (bf16_t*)(lds + 36864); bf16_t* hqL = (bf16_t*)(lds + 36864 + 16384); bf16_t* hiL = (bf16_t*)(lds + 36864 + 32768);
    { u32x4 t[6];
#pragma unroll
      for (int j = 0; j < 2; ++j) { const int ci = tid + 512 * j, row = ci >> 4, c16 = ci & 15; const bf16_t* rp = P + (size_t)row * LD + h * 128 + c16 * 8;
          t[j] = *(const u32x4*)(rp + C_HF); t[2 + j] = *(const u32x4*)(rp + C_HQ); t[4 + j] = *(const u32x4*)(rp + C_HI); }
#pragma unroll
      for (int j = 0; j < 2; ++j) { const int ci = tid + 512 * j; *(u32x4*)(zL + ci * 8) = t[j]; *(u32x4*)(hqL + ci * 8) = t[2 + j]; *(u32x4*)(hiL + ci * 8) = t[4 + j]; } }
    __syncthreads();
    const int e = tid & 127, qd = tid >> 7;
    const float lb = ((const float*)(a.ws + WS_LBS))[layer * 512 + h * 128 + e];
    const float la = __logf(fmaxf(lb, 1e-30f)), l1 = log1pf(-lb), oml = 1.f - lb;
    float bl[16], kq[16], qq[16]; float run = 0.f;
#pragma unroll
    for (int j = 0; j < 16; ++j) {
        const int s = 16 * qd + j;
        const float z = bf2f(zL[s * 128 + e]);
        const float ez = __expf(-fabsf(z)), lsz = fminf(z, 0.f) - __logf(1.f + ez);
        const float b2 = l1 + lsz, mx = fmaxf(la, b2), lf = mx + __logf(1.f + __expf(-fabsf(la - b2)));
        run += lf; bl[j] = run;
        const float rc = __builtin_amdgcn_rcpf(1.f + ez);
        kq[j] = oml * (z >= 0.f ? ez * rc : rc);
        const float hq = bf2f(hqL[s * 128 + e]);
        qq[j] = hq * fast_sigmoid(hq);
    }
    tot[qd * 128 + e] = run;
    __syncthreads();
    const float t0 = tot[e], t1 = tot[128 + e], t2 = tot[256 + e], t3 = tot[384 + e];
    const float off = (qd > 0 ? t0 : 0.f) + (qd > 1 ? t1 : 0.f) + (qd > 2 ? t2 : 0.f);
    const float blast = ((t0 + t1) + t2) + t3, rmid = t0 + t1;
    unsigned k2p[8]; float k2prev = 0.f;
#pragma unroll
    for (int j = 0; j < 16; ++j) {
        const int s = 16 * qd + j; const float bb = bl[j] + off;
        const float q1 = qq[j] * __expf(bb), qm = qq[j] * __expf(fminf(bb - rmid, 80.f)), km = kq[j] * __expf(fminf(rmid - bb, 80.f)), k2 = kq[j] * __expf(blast - bb);
        Q1[s * 128 + e] = (bf16_t)(cvt_pk_bf16(q1, 0.f) & 0xffffu);
        qmL[s * 136 + e] = (bf16_t)(cvt_pk_bf16(qm, 0.f) & 0xffffu);
        kmL[s * 136 + e] = (bf16_t)(cvt_pk_bf16(km, 0.f) & 0xffffu);
        if (j & 1) k2p[j >> 1] = cvt_pk_bf16(k2prev, k2); else k2prev = k2;
    }
    { u32x4 w0 = {k2p[0], k2p[1], k2p[2], k2p[3]}, w1 = {k2p[4], k2p[5], k2p[6], k2p[7]};
      *(u32x4*)(K2T + e * 64 + 16 * qd) = w0; *(u32x4*)(K2T + e * 64 + 16 * qd + 8) = w1; }
    if (qd == 0) DEC[e] = __expf(blast);
    { unsigned vp[8]; unsigned prev = 0;
#pragma unroll
      for (int j = 0; j < 16; ++j) { const unsigned hv = hiL[(16 * qd + j) * 128 + e]; if (j & 1) vp[j >> 1] = prev | (hv << 16); else prev = hv; }
      u32x4 w0 = {vp[0], vp[1], vp[2], vp[3]}, w1 = {vp[4], vp[5], vp[6], vp[7]};
      *(u32x4*)(VT + e * 64 + 16 * qd) = w0; *(u32x4*)(VT + e * 64 + 16 * qd + 8) = w1; }
    __syncthreads();
    const int r = lane & 15, g = lane >> 4;
#pragma unroll
    for (int q = 0; q < 2; ++q) {
        const int id = 2 * wave + q, tt = id >> 2, st = id & 3;
        f32x4 acc = {0.f, 0.f, 0.f, 0.f};
        if (st <= tt) {
#pragma unroll
            for (int kk = 0; kk < 4; ++kk) {
                const bf16x8 av = *(const bf16x8*)(qmL + (16 * tt + r) * 136 + 32 * kk + 8 * g);
                const bf16x8 bv = *(const bf16x8*)(kmL + (16 * st + r) * 136 + 32 * kk + 8 * g);
                acc = __builtin_amdgcn_mfma_f32_16x16x32_bf16(av, bv, acc, 0, 0, 0);
            }
        }
#pragma unroll
        for (int i = 0; i < 4; ++i) { const int t = 16 * tt + 4 * g + i, s = 16 * st + r; const float val = (s <= t) ? acc[i] : 0.f;
            AM[t * 64 + s] = (bf16_t)(cvt_pk_bf16(val, 0.f) & 0xffffu); }
    }
    __syncthreads();
}

constexpr int CH_Q1 = 0, CH_AM = 18432, CH_K2 = 28672, CH_DEC = 49152, CH_BUF = 50176, CH_PART = 2 * CH_BUF;
struct ChainRegs { u32x4 q[2], k[2], am, dc; bf16x8 vf[2]; };
DI void chain_fetch(const Args& a, int item, int tid, int w, int r, int g, ChainRegs& R) {
    const bf16_t* __restrict__ q1 = (const bf16_t*)(a.ws + WS_Q1) + (size_t)item * 8192; const bf16_t* __restrict__ k2t = (const bf16_t*)(a.ws + WS_K2T) + (size_t)item * 8192;
    const bf16_t* __restrict__ vt = (const bf16_t*)(a.ws + WS_VT) + (size_t)item * 8192; const bf16_t* __restrict__ am = (const bf16_t*)(a.ws + WS_AM) + (size_t)item * 4096;
    const float* __restrict__ dec = (const float*)(a.ws + WS_DEC) + (size_t)item * 128;
#pragma unroll
    for (int j = 0; j < 2; ++j) { R.q[j] = *(const u32x4*)(q1 + (tid + 512 * j) * 8); R.k[j] = *(const u32x4*)(k2t + (tid + 512 * j) * 8); }
    R.am = *(const u32x4*)(am + tid * 8);
    R.dc = *(const u32x4*)(dec + (tid & 31) * 4);
#pragma unroll
    for (int ks = 0; ks < 2; ++ks) R.vf[ks] = *(const bf16x8*)(vt + (16 * w + r) * 64 + 32 * ks + 8 * g);
}
DI void chain_stash(unsigned char* buf, int tid, const ChainRegs& R) {
#pragma unroll
    for (int j = 0; j < 2; ++j) {
        const int ci = tid + 512 * j;
        *(u32x4*)(buf + CH_Q1 + (ci >> 4) * 288 + (ci & 15) * 16) = R.q[j];
        const int e = ci >> 3, wi = e & 31, row = 16 * (2 * (e >> 5) + ((wi >> 2) & 1)) + 4 * (wi >> 3) + (wi & 3);
        *(u32x4*)(buf + CH_K2 + row * 160 + (ci & 7) * 16) = R.k[j];
    }
    *(u32x4*)(buf + CH_AM + (tid >> 3) * 160 + (tid & 7) * 16) = R.am;
    if (tid < 32) *(u32x4*)(buf + CH_DEC + tid * 16) = R.dc;
}
DI void hgrn_chain(const Args& a, int layer, int bh, unsigned char* lds, int tid, int lane, int wave) {
    const int b = bh >> 2, h = bh & 3, r = lane & 15, g = lane >> 4, w = wave;
    const bf16_t* __restrict__ Pg = (const bf16_t*)(a.ws + WS_PROJ) + C_HG + h * 128 + 16 * w + r;
    bf16_t* __restrict__ Po = (bf16_t*)(a.ws + WS_PROJ) + C_HQ + h * 128 + 16 * w + r;
    float* part = (float*)(lds + CH_PART);
    const float nw = a.hon[layer * 512 + h * 128 + 16 * w + r];
    f32x4 S[4][2];
#pragma unroll
    for (int eb = 0; eb < 4; ++eb) { S[eb][0] = (f32x4){0.f, 0.f, 0.f, 0.f}; S[eb][1] = (f32x4){0.f, 0.f, 0.f, 0.f}; }
    ChainRegs R;
    chain_fetch(a, bh * 32, tid, w, r, g, R);
    chain_stash(lds, tid, R);
    bf16x8 vf[2] = {R.vf[0], R.vf[1]};
    asm volatile("" : "+v"(vf[0]), "+v"(vf[1]));
    chain_fetch(a, bh * 32 + 1, tid, w, r, g, R);
    __syncthreads();
#define CH_SCHED __builtin_amdgcn_sched_barrier(0)
#pragma unroll 1
    for (int c = 0; c < 32; ++c) {
        const int m0 = b * T + c * 64;
        const unsigned char* buf = lds + (c & 1) * CH_BUF;
        unsigned short gt[4][4];
#pragma unroll
        for (int tt = 0; tt < 4; ++tt)
#pragma unroll
            for (int i = 0; i < 4; ++i) gt[tt][i] = Pg[(size_t)(m0 + 16 * tt + 4 * g + i) * LD];
        bf16x8 sb[4];
#pragma unroll
        for (int eb = 0; eb < 4; ++eb) {
            u32x4 t; t.x = cvt_pk_bf16(S[eb][0][0], S[eb][0][1]); t.y = cvt_pk_bf16(S[eb][0][2], S[eb][0][3]); t.z = cvt_pk_bf16(S[eb][1][0], S[eb][1][1]); t.w = cvt_pk_bf16(S[eb][1][2], S[eb][1][3]);
            sb[eb] = __builtin_bit_cast(bf16x8, t);
        }
        f32x4 o[4]; bf16x8 fa[2][6];
#define CH_LOADF(tt, dst) do { _Pragma("unroll") for (int eb = 0; eb < 4; ++eb) dst[eb] = *(const bf16x8*)(buf + CH_Q1 + (16 * (tt) + r) * 288 + (32 * eb + 8 * g) * 2); \
                               _Pragma("unroll") for (int ks = 0; ks < 2; ++ks) dst[4 + ks] = *(const bf16x8*)(buf + CH_AM + (16 * (tt) + r) * 160 + (32 * ks + 8 * g) * 2); } while (0)
        CH_LOADF(0, fa[0]);
#pragma unroll
        for (int tt = 0; tt < 4; ++tt) {
            if (tt < 3) CH_LOADF(tt + 1, fa[(tt + 1) & 1]);
            CH_SCHED;
            o[tt] = (f32x4){0.f, 0.f, 0.f, 0.f};
#pragma unroll
            for (int eb = 0; eb < 4; ++eb) o[tt] = __builtin_amdgcn_mfma_f32_16x16x32_bf16(fa[tt & 1][eb], sb[eb], o[tt], 0, 0, 0);
#pragma unroll
            for (int ks = 0; ks < 2; ++ks) o[tt] = __builtin_amdgcn_mfma_f32_16x16x32_bf16(fa[tt & 1][4 + ks], vf[ks], o[tt], 0, 0, 0);
            CH_SCHED;
        }
        bf16x8 fk[2][4]; f32x4 fd[2][2];
#define CH_LOADK(eb, dk, dd) do { _Pragma("unroll") for (int hh = 0; hh < 2; ++hh) { dd[hh] = *(const f32x4*)(buf + CH_DEC + (32 * (eb) + 8 * g + 4 * hh) * 4); \
                               _Pragma("unroll") for (int ks = 0; ks < 2; ++ks) dk[2 * hh + ks] = *(const bf16x8*)(buf + CH_K2 + (16 * (2 * (eb) + hh) + r) * 160 + (32 * ks + 8 * g) * 2); } } while (0)
        CH_LOADK(0, fk[0], fd[0]);
#pragma unroll
        for (int eb = 0; eb < 4; ++eb) {
            if (eb < 3) CH_LOADK(eb + 1, fk[(eb + 1) & 1], fd[(eb + 1) & 1]);
            CH_SCHED;
#pragma unroll
            for (int hh = 0; hh < 2; ++hh) {
                S[eb][hh] = S[eb][hh] * fd[eb & 1][hh];
#pragma unroll
                for (int ks = 0; ks < 2; ++ks) S[eb][hh] = __builtin_amdgcn_mfma_f32_16x16x32_bf16(fk[eb & 1][2 * hh + ks], vf[ks], S[eb][hh], 0, 0, 0);
            }
            CH_SCHED;
        }
        float* pb = part + (c & 1) * 512;
#pragma unroll
        for (int tt = 0; tt < 4; ++tt) {
            f32x4 sq = o[tt] * o[tt];
#pragma unroll
            for (int i = 0; i < 4; ++i) sq[i] = row16_sum(sq[i]);
            if (r == 0) *(f32x4*)(pb + w * 64 + 16 * tt + 4 * g) = sq;
        }
        chain_stash(lds + ((c + 1) & 1) * CH_BUF, tid, R);
        vf[0] = R.vf[0]; vf[1] = R.vf[1];
        asm volatile("" : "+v"(vf[0]), "+v"(vf[1]));
        chain_fetch(a, bh * 32 + (c < 30 ? c + 2 : 31), tid, w, r, g, R);
        __syncthreads();
#pragma unroll
        for (int tt = 0; tt < 4; ++tt) {
            f32x4 pv[8];
#pragma unroll
            for (int ww = 0; ww < 8; ++ww) pv[ww] = *(const f32x4*)(pb + ww * 64 + 16 * tt + 4 * g);
            CH_SCHED;
            const f32x4 tot = ((pv[0] + pv[1]) + (pv[2] + pv[3])) + ((pv[4] + pv[5]) + (pv[6] + pv[7]));
#pragma unroll
            for (int i = 0; i < 4; ++i) {
                const int t = 16 * tt + 4 * g + i; const float rs = __builtin_amdgcn_rsqf(tot[i] * (1.0f / 128.f) + EPS);
                const float val = o[tt][i] * rs * nw * fast_sigmoid(bf2f(gt[tt][i]));
                Po[(size_t)(m0 + t) * LD] = (bf16_t)(cvt_pk_bf16(val, 0.f) & 0xffffu);
            }
        }
    }
#undef CH_LOADF
#undef CH_LOADK
#undef CH_SCHED
    __syncthreads();
}

typedef short s16x4 __attribute__((ext_vector_type(4)));
struct AttnState { float l[2]; f32x4 O[2][4]; };
struct AttnTile { bf16x8 kf[2][2]; u32x4 vv[4]; f32x4 c0, c1; };
constexpr float LOG2E = 1.4426950408889634f;
template <int MODE>
DI void attn_load(const bf16_t* P, const float* cb, int mb, int kcol, int vcol, int kb0, int ks, int j, int lane, AttnTile& t) {
    const int r = lane & 15, g = lane >> 4, sb0 = 32 * j;
#pragma unroll
    for (int h2 = 0; h2 < 2; ++h2) {
        int tk = kb0 + (sb0 + 8 * (r >> 2) + 4 * h2 + (r & 3)) * ks; tk = tk < 0 ? 0 : (tk > T - 1 ? T - 1 : tk);
        const bf16_t* kp = P + (size_t)(mb + tk) * LD + kcol + 8 * g;
        t.kf[h2][0] = *(const bf16x8*)kp; t.kf[h2][1] = *(const bf16x8*)(kp + 32);
    }
#pragma unroll
    for (int q4 = 0; q4 < 4; ++q4) {
        int tk = kb0 + (sb0 + 8 * q4 + (lane >> 3)) * ks; tk = tk < 0 ? 0 : (tk > T - 1 ? T - 1 : tk);
        t.vv[q4] = *(const u32x4*)(P + (size_t)(mb + tk) * LD + vcol + 8 * (lane & 7));
    }
    if (MODE == 0) { t.c0 = *(const f32x4*)(cb + sb0 + 8 * g); t.c1 = *(const f32x4*)(cb + sb0 + 8 * g + 4); }
}
template <int MODE, bool MASKED>
DI void attn_qtile(const AttnTile& cu, const bf16x8 (&qf)[2], const bf16x8 (&vt)[4], float cq, int tq, int kb0, int ks, int sb0, int g, float& l, f32x4 (&O)[4]) {
    f32x4 s[2];
#pragma unroll
    for (int h2 = 0; h2 < 2; ++h2) { s[h2] = __builtin_amdgcn_mfma_f32_16x16x32_bf16(cu.kf[h2][0], qf[0], (f32x4){0.f, 0.f, 0.f, 0.f}, 0, 0, 0); s[h2] = __builtin_amdgcn_mfma_f32_16x16x32_bf16(cu.kf[h2][1], qf[1], s[h2], 0, 0, 0); }
    float p[8], ps = 0.f;
#pragma unroll
    for (int idx = 0; idx < 8; ++idx) {
        float v = s[idx >> 2][idx & 3] * (0.125f * LOG2E);
        if (MODE == 0) v += (cq - (idx < 4 ? cu.c0[idx & 3] : cu.c1[idx & 3])) * LOG2E;
        float e = __builtin_amdgcn_exp2f(fminf(v, 115.f));
        if (MASKED) {
            const int tk = kb0 + (sb0 + 8 * g + idx) * ks;
            const bool ok = (MODE == 0) ? (tk <= tq) : ((tk >= 0) && (tk <= tq) && (tq - tk <= 128 * ks));
            e = ok ? e : 0.f;
        }
        p[idx] = e; ps += e;
    }
    l += ps;
    u32x4 pw; pw.x = cvt_pk_bf16(p[0], p[1]); pw.y = cvt_pk_bf16(p[2], p[3]); pw.z = cvt_pk_bf16(p[4], p[5]); pw.w = cvt_pk_bf16(p[6], p[7]);
    const bf16x8 pf = __builtin_bit_cast(bf16x8, pw);
#pragma unroll
    for (int db = 0; db < 4; ++db) O[db] = __builtin_amdgcn_mfma_f32_16x16x32_bf16(vt[db], pf, O[db], 0, 0, 0);
}
template <int MODE>
DI void attn_seg(const bf16_t* P, const float* cb, int mb, int q0, int qs, int kcol, int vcol, int kb0, int ks, int jlo, int nt, const bf16x8 (&qf)[2][2], const float (&cq)[2], AttnState& st, unsigned char* vl, int lane) {
    const int r = lane & 15, g = lane >> 4;
    if (jlo >= nt) return;
    AttnTile nx;
    attn_load<MODE>(P, cb, mb, kcol, vcol, kb0, ks, jlo, lane, nx);
#pragma unroll 1
    for (int j = jlo; j < nt; ++j) {
        const int sb0 = 32 * j;
        AttnTile cu = nx;
        if (j + 1 < nt) attn_load<MODE>(P, cb, mb, kcol, vcol, kb0, ks, j + 1, lane, nx);
#pragma unroll
        for (int q4 = 0; q4 < 4; ++q4) *(u32x4*)(vl + (8 * q4 + (lane >> 3)) * 144 + (lane & 7) * 16) = cu.vv[q4];
        bf16x8 vt[4];
        {
            s16x4 lo0, lo1, lo2, lo3, hi0, hi1, hi2, hi3;
            const unsigned ad = (unsigned)(uintptr_t)(vl + (8 * g + (r >> 2)) * 144 + (r & 3) * 8);
            asm volatile("s_waitcnt lgkmcnt(0)\n\t"
                         "ds_read_b64_tr_b16 %0, %8\n\tds_read_b64_tr_b16 %1, %8 offset:32\n\tds_read_b64_tr_b16 %2, %8 offset:64\n\tds_read_b64_tr_b16 %3, %8 offset:96\n\t"
                         "ds_read_b64_tr_b16 %4, %8 offset:576\n\tds_read_b64_tr_b16 %5, %8 offset:608\n\tds_read_b64_tr_b16 %6, %8 offset:640\n\tds_read_b64_tr_b16 %7, %8 offset:672\n\t"
                         "s_waitcnt lgkmcnt(0)"
                         : "=&v"(lo0), "=&v"(lo1), "=&v"(lo2), "=&v"(lo3), "=&v"(hi0), "=&v"(hi1), "=&v"(hi2), "=&v"(hi3) : "v"(ad) : "memory");
            vt[0] = __builtin_shufflevector(lo0, hi0, 0, 1, 2, 3, 4, 5, 6, 7); vt[1] = __builtin_shufflevector(lo1, hi1, 0, 1, 2, 3, 4, 5, 6, 7);
            vt[2] = __builtin_shufflevector(lo2, hi2, 0, 1, 2, 3, 4, 5, 6, 7); vt[3] = __builtin_shufflevector(lo3, hi3, 0, 1, 2, 3, 4, 5, 6, 7);
        }
#pragma unroll
        for (int qi = 0; qi < 2; ++qi) {
            const int tq = q0 + (16 * qi + r) * qs;
            const int tqmin = q0 + 16 * qi * qs, tqmax = tqmin + 15 * qs, tklo = kb0 + sb0 * ks, tkhi = tklo + 31 * ks;
            bool interior;
            if (MODE == 0) interior = tkhi <= tqmin;
            else {
                if (tkhi < tqmin - 128 * ks || tklo > tqmax) continue;
                interior = (tklo >= 0) && (tklo >= tqmax - 128 * ks) && (tkhi <= tqmin);
            }
            if (interior) attn_qtile<MODE, false>(cu, qf[qi], vt, cq[qi], tq, kb0, ks, sb0, g, st.l[qi], st.O[qi]);
            else attn_qtile<MODE, true>(cu, qf[qi], vt, cq[qi], tq, kb0, ks, sb0, g, st.l[qi], st.O[qi]);
        }
    }
}

DI void attn_item(const Args& a, int x, int idx, unsigned char* vl, int lane) {
    bf16_t* P = (bf16_t*)(a.ws + WS_PROJ);
    const int r = lane & 15, g = lane >> 4;
    const bool fox = idx < 256;
    int bh, q0, qs;
    if (fox) { bh = 4 * x + (idx & 3); q0 = 32 * (63 - (idx >> 2)); qs = 1; }
    else { const int i = idx - 256; bh = 4 * x + (i & 3); const int rest = i >> 2; q0 = 512 * (rest >> 4) + (rest & 15); qs = 16; }
    const int b = bh >> 2, h = bh & 3, mb = b * T;
    const int qcol = (fox ? C_FQ : C_DQ) + h * 64;
    bf16x8 qf[2][2];
#pragma unroll
    for (int qi = 0; qi < 2; ++qi) { const bf16_t* qp = P + (size_t)(mb + q0 + (16 * qi + r) * qs) * LD + qcol + 8 * g; qf[qi][0] = *(const bf16x8*)qp; qf[qi][1] = *(const bf16x8*)(qp + 32); }
    AttnState st; float cq[2] = {0.f, 0.f};
#pragma unroll
    for (int qi = 0; qi < 2; ++qi) { st.l[qi] = 0.f;
#pragma unroll
        for (int db = 0; db < 4; ++db) st.O[qi][db] = (f32x4){0.f, 0.f, 0.f, 0.f}; }
    if (fox) {
        const float* cb = (const float*)(a.ws + WS_CARR) + (size_t)bh * T;
        cq[0] = cb[q0 + r]; cq[1] = cb[q0 + 16 + r];
        attn_seg<0>(P, cb, mb, q0, 1, C_FK + h * 64, C_FV + h * 64, 0, 1, 0, (q0 >> 5) + 1, qf, cq, st, vl, lane);
    } else {
        const int kcol = C_DK + h * 64, vcol = C_DV + h * 64;
#pragma unroll 1
        for (int br = 0; br < 3; ++br) {
            const int ks = br == 0 ? 1 : (br == 1 ? 4 : 16), nt = br == 0 ? 20 : (br == 1 ? 8 : 5);
            const int kb0 = q0 - 128 * ks;
            const int fv = kb0 >= 0 ? 0 : (-kb0 + ks - 1) / ks;
            attn_seg<1>(P, nullptr, mb, q0, 16, kcol, vcol, kb0, ks, fv >> 5, nt, qf, cq, st, vl, lane);
        }
    }
#pragma unroll
    for (int qi = 0; qi < 2; ++qi) {
        float lt = st.l[qi]; lt += shfl_lane(lt, lane ^ 16); lt += shfl_lane(lt, lane ^ 32);
        const float inv = 1.0f / lt;
        bf16_t* op = P + (size_t)(mb + q0 + (16 * qi + r) * qs) * LD + qcol + 4 * g;
#pragma unroll
        for (int db = 0; db < 4; ++db) { u32x2 w; w.x = cvt_pk_bf16(st.O[qi][db][0] * inv, st.O[qi][db][1] * inv); w.y = cvt_pk_bf16(st.O[qi][db][2] * inv, st.O[qi][db][3] * inv); *(u32x2*)(op + 16 * db) = w; }
    }
}


#define XB_TMO      128
#define XB_XCNT(j)  (256  + 64 * (j))
#define XB_XSUB(j)  (1280 + 64 * (j))
#define XB_XGEN(j)  (2304 + 64 * (j))
#define XB_TOP      3328
#define XB_TOPGEN   3392
#define XCD_BAR_WORDS 3456
#define XB_SPIN_CAP (1u << 22)
DI unsigned xb_ld(unsigned* p)              { return __hip_atomic_load(p, __ATOMIC_RELAXED, __HIP_MEMORY_SCOPE_AGENT); }
DI unsigned xb_add(unsigned* p, unsigned v) { return __hip_atomic_fetch_add(p, v, __ATOMIC_RELAXED, __HIP_MEMORY_SCOPE_AGENT); }
DI unsigned xb_xcc_id() { return (unsigned)__builtin_amdgcn_s_getreg((3 << 11) | 20) & 0xFu; }
#define XB_SPIN(cond, bar) do { unsigned _sp = 0; while (cond) { __builtin_amdgcn_s_sleep(1); \
    if ((++_sp & 255u) == 0u) { if (xb_ld(&(bar)[XB_TMO])) break; if (_sp > XB_SPIN_CAP) { atomicAdd(&(bar)[XB_TMO], 1u); break; } } } } while (0)
DI void xcd_barrier_complete(unsigned* bar, unsigned x, unsigned& nloc, unsigned& nx) {
    const unsigned G = gridDim.x * gridDim.y * gridDim.z;
    unsigned sum, cnt, mine, sp = 0u;
    for (;;) {
        sum = 0u; cnt = 0u; mine = 0u;
#pragma unroll
        for (unsigned j = 0; j < 16; ++j) { const unsigned c = xb_ld(&bar[XB_XCNT(j)]); sum += c; cnt += (c > 0u) ? 1u : 0u; mine = (j == x) ? c : mine; }
        if (sum == G) break;
        __builtin_amdgcn_s_sleep(1);
        if ((++sp & 255u) == 0u) { if (xb_ld(&bar[XB_TMO])) break; if (sp > XB_SPIN_CAP) { atomicAdd(&bar[XB_TMO], 1u); break; } }
    }
    nloc = mine > 0u ? mine : 1u; nx = cnt > 0u ? cnt : 1u;
}
DI void xcd_barrier(unsigned* bar, volatile PG8_LAS unsigned* st) {
    asm volatile("s_waitcnt vmcnt(0)" ::: "memory");
    __syncthreads();
    if (threadIdx.x == 0) {
        const unsigned x = xb_xcc_id();
        __builtin_amdgcn_s_waitcnt(0);
        unsigned nloc = st[0], nx = st[1];
        if (nloc == 0u) { xcd_barrier_complete(bar, x, nloc, nx); st[0] = nloc; st[1] = nx; }
        const unsigned old = xb_add(&bar[XB_XSUB(x)], 1u);
        const unsigned gen = old / nloc;
        if (old + 1u == (gen + 1u) * nloc) {
            __builtin_amdgcn_fence(__ATOMIC_RELEASE, "agent");
            asm volatile("s_waitcnt vmcnt(0)" ::: "memory");
            const unsigned og = xb_add(&bar[XB_TOP], 1u);
            const unsigned tg = og / nx;
            if (og + 1u == (tg + 1u) * nx) xb_add(&bar[XB_TOPGEN], 1u);
            else XB_SPIN(xb_ld(&bar[XB_TOPGEN]) == tg, bar);
            __builtin_amdgcn_fence(__ATOMIC_ACQUIRE, "agent");
            xb_add(&bar[XB_XGEN(x)], 1u);
            asm volatile("s_waitcnt vmcnt(0)" ::: "memory");
        } else {
            XB_SPIN(xb_ld(&bar[XB_XGEN(x)]) == gen, bar);
            __builtin_amdgcn_fence(__ATOMIC_ACQUIRE, "agent");
            asm volatile("s_waitcnt vmcnt(0)" ::: "memory");
        }
    }
    __syncthreads();
}

__global__ void __launch_bounds__(512, 2) fwd_megakernel(Args a) {
    extern __shared__ __attribute__((aligned(16))) unsigned char lds[];
    cg::grid_group grid = cg::this_grid();
    const int tid = threadIdx.x, lane = tid & 63, wave = __builtin_amdgcn_readfirstlane(tid >> 6);
    const int G = gridDim.x;
    const int wave_s = __builtin_amdgcn_readfirstlane(threadIdx.x >> 6);
    constexpr int BAR_WORD0 = 4096, LDS_MISC = 132096;
    if (threadIdx.x == 0) { ((volatile PG8_LAS unsigned*)((PG8_LAS unsigned char*)lds + LDS_MISC))[0] = 0u; ((volatile PG8_LAS unsigned*)((PG8_LAS unsigned char*)lds + LDS_MISC))[1] = 0u;
        (void)xb_add((unsigned*)(a.ws + WS_CTL) + BAR_WORD0 + XB_XCNT(xb_xcc_id()), 1u); }
    __syncthreads();
    float* out = a.out;

    prologue(a, lds, tid, lane, wave);
    if (G == 0x7fffffff) grid.sync();
    xcd_barrier((unsigned*)(a.ws + WS_CTL) + BAR_WORD0, (volatile PG8_LAS unsigned*)((PG8_LAS unsigned char*)lds + LDS_MISC));

#pragma unroll 1
    for (int op = 0; op < DEPTH * 8; ++op) {
        const int l = op >> 3, k = op & 7;
        int lane = (int)__builtin_amdgcn_mbcnt_hi(~0u, __builtin_amdgcn_mbcnt_lo(~0u, 0u)); asm volatile("" : "+v"(lane));
        const int wave = wave_s, tid = wave_s * 64 + lane;
        unsigned long long lz = 0; asm volatile("" : "+s"(lz));
        unsigned char* ws = a.ws + lz;
        Args al = a; al.ws = ws;
        float* out = a.out; bf16_t* xb = (bf16_t*)(ws + WS_XB); float* ssq = (float*)(ws + WS_SSQ); bf16_t* proj = (bf16_t*)(ws + WS_PROJ);
        const unsigned char* wl = ws + WS_W + (size_t)l * W_LAYER;
        if (k == 0 || k == 6) {
            pg8::Gemm g{xb, (const bf16_t*)(wl + (k == 0 ? WO_GU1 : WO_GU2)), M, NGU, D, D, D};
            pg8::StaticOrder S; S.init(M, NGU, G, (int)blockIdx.x);
            EpiSwiGLU E{proj, ssq};
            pg8::gemm_phase<EpiSwiGLU, true>((PG8_LAS unsigned char*)lds, g, S, E, tid);
        } else if (k == 1 || k == 7 || k == 5) {
            const bool isout = (k == 5);
            pg8::Gemm g{proj, (const bf16_t*)(wl + (k == 1 ? WO_D1 : (k == 7 ? WO_D2 : WO_OUT))), M, D, isout ? D : DFF, isout ? LD : DFF, isout ? D : DFF};
            pg8::StaticOrder S; S.init(M, D, G, (int)blockIdx.x);
            EpiResid E{xb, ssq, isout ? 1.0f : 0.5f};
            pg8::gemm_phase<EpiResid, false>((PG8_LAS unsigned char*)lds, g, S, E, tid);
        } else if (k == 2) {
            pg8::Gemm g{xb, (const bf16_t*)(wl + WO_IN), M, LD, D, D, D};
            pg8::StaticOrder S; S.init(M, LD, G, (int)blockIdx.x);
            EpiProj E{proj, ssq, (const float*)(ws + WS_ROPE), (float*)(ws + WS_FFB)};
            pg8::gemm_phase<EpiProj, true>((PG8_LAS unsigned char*)lds, g, S, E, tid);
        } else if (k == 3) {
            if (blockIdx.x < 32) fox_scan(al, l, (int)blockIdx.x, lds, tid, lane, wave);
            for (int it = blockIdx.x; it < 1024; it += G) hgrn_prep(al, l, it, lds, tid, lane, wave);
        } else {
            if (blockIdx.x < 32) hgrn_chain(al, l, (int)blockIdx.x, lds, tid, lane, wave);
            unsigned char* vl = lds + wave * 4608;
            const int x0 = (int)(blockIdx.x & 7);
#pragma unroll 1
            for (int dx = 0; dx < 8; ++dx) {
                const int x = (x0 + dx) & 7;
                unsigned* ctr = (unsigned*)(ws + WS_CTL) + 64 * (l * 8 + x);
                if (__hip_atomic_load(ctr, __ATOMIC_RELAXED, __HIP_MEMORY_SCOPE_AGENT) >= 512u) continue;
                for (;;) {
                    unsigned it = 0;
                    if (lane == 0) it = atomicAdd(ctr, 1u);
                    it = __builtin_amdgcn_readfirstlane(it);
                    if (it >= 512u) break;
                    attn_item(al, x, (int)it, vl, lane);
                }
            }
        }
        xcd_barrier((unsigned*)(ws + WS_CTL) + BAR_WORD0, (volatile PG8_LAS unsigned*)((PG8_LAS unsigned char*)lds + LDS_MISC));
    }
    {
        int lane = (int)__builtin_amdgcn_mbcnt_hi(~0u, __builtin_amdgcn_mbcnt_lo(~0u, 0u)); asm volatile("" : "+v"(lane));
        const int wave = wave_s;
        const int gw = blockIdx.x * 8 + wave, NGW = G * 8;
        const bf16_t* xbf = (const bf16_t*)(a.ws + WS_XB);
        for (int m = gw; m < M; m += NGW) {
            const u32x2* xr = (const u32x2*)(xbf + (size_t)m * D) + lane; f32x4* orow = (f32x4*)(out + (size_t)m * D) + lane; f32x4 v[4]; float s = 0.f;
#pragma unroll
            for (int j = 0; j < 4; ++j) { const u32x2 wv = xr[64 * j]; v[j] = (f32x4){__uint_as_float(wv.x << 16), __uint_as_float(wv.x & 0xffff0000u), __uint_as_float(wv.y << 16), __uint_as_float(wv.y & 0xffff0000u)};
                s += (v[j][0] * v[j][0] + v[j][1] * v[j][1]) + (v[j][2] * v[j][2] + v[j][3] * v[j][3]); }
#pragma unroll
            for (int o = 1; o < 64; o <<= 1) s += shfl_lane(s, lane ^ o);
            const float rs = 1.0f / sqrtf(s * (1.0f / D) + EPS);
#pragma unroll
            for (int j = 0; j < 4; ++j) { const f32x4 gn = ((const f32x4*)a.fn)[lane + 64 * j]; orow[64 * j] = v[j] * rs * gn; }
        }
    }
}

extern "C" void kernel_launch(void* const* d_in, const int* in_sizes, int n_in, void* d_out, int out_size, void* d_ws, size_t ws_size, hipStream_t stream) {
    static int grid = 0;
    if (grid == 0) {
        if (n_in != 17 || out_size != M * D || ws_size < WS_END) { fprintf(stderr, "kernel_launch: unexpected shapes / workspace (n_in %d out %d ws %zu)\n", n_in, out_size, ws_size); grid = -1; return; }
        int dev = 0, cus = 0, per_cu = 0;
        (void)hipGetDevice(&dev);
        (void)hipDeviceGetAttribute(&cus, hipDeviceAttributeMultiprocessorCount, dev);
        (void)hipFuncSetAttribute((const void*)fwd_megakernel, hipFuncAttributeMaxDynamicSharedMemorySize, LDS_BYTES);
        (void)hipOccupancyMaxActiveBlocksPerMultiprocessor(&per_cu, (const void*)fwd_megakernel, 512, LDS_BYTES);
        (void)hipGetLastError();
        if (per_cu < 1) per_cu = 1;
        grid = cus * per_cu;
    }
    if (grid < 0) return;
    (void)hipMemsetAsync((char*)d_ws + WS_CTL, 0, 32768, stream);
    Args a{};
    a.x = (const float*)d_in[0]; a.pos = (const int*)d_in[1];
    a.f1n = (const float*)d_in[2]; a.f1g = (const float*)d_in[3]; a.f1u = (const float*)d_in[4]; a.f1d = (const float*)d_in[5];
    a.mn = (const float*)d_in[6]; a.win = (const float*)d_in[7]; a.fb = (const float*)d_in[8]; a.hlb = (const float*)d_in[9]; a.hon = (const float*)d_in[10];
    a.wout = (const float*)d_in[11]; a.f2n = (const float*)d_in[12]; a.f2g = (const float*)d_in[13]; a.f2u = (const float*)d_in[14]; a.f2d = (const float*)d_in[15];
    a.fn = (const float*)d_in[16];
    a.out = (float*)d_out; a.ws = (unsigned char*)d_ws;
    void* args[] = {&a};
    hipError_t e = hipLaunchCooperativeKernel((const void*)fwd_megakernel, dim3(grid), dim3(512), args, LDS_BYTES, stream);
    if (e != hipSuccess) fprintf(stderr, "cooperative launch failed: %s (grid %d)\n", hipGetErrorString(e), grid);
}
```

```cpp
#include <hip/hip_runtime.h>
#include <hip/hip_cooperative_groups.h>
#include <cstdio>
#include <cstdint>
namespace cg = cooperative_groups;

#define DI __device__ __forceinline__
typedef unsigned short bf16_t;
typedef short bf16x8 __attribute__((ext_vector_type(8)));
typedef float f32x4 __attribute__((ext_vector_type(4)));
typedef unsigned u32x4 __attribute__((ext_vector_type(4)));
typedef unsigned u32x2 __attribute__((ext_vector_type(2)));

constexpr int BATCH = 8, T = 2048, D = 1024, DEPTH = 4, M = BATCH * T, DFF = 2816, NIN = 3588, LD = 3840;
constexpr int NGU = 2 * DFF;
constexpr int C_FQ = 0, C_DQ = 256, C_HQ = 512, C_FK = 1024, C_FV = 1280, C_DK = 1536, C_DV = 1792, C_HF = 2048, C_HI = 2560, C_HG = 3072, C_FF = 3584;
constexpr int S_FQ = 0, S_FK = 256, S_FV = 512, S_FF = 768, S_DQ = 772, S_DK = 1028, S_DV = 1284, S_HQ = 1540, S_HF = 2052, S_HI = 2564, S_HG = 3076;
constexpr float EPS = 1e-6f;

constexpr size_t MiB = 1u << 20;
constexpr size_t WS_CTL = 0, WS_SSQ = 1 * MiB, WS_ROPE = 2 * MiB, WS_FFB = 3 * MiB, WS_CARR = 3 * MiB + 256 * 1024, WS_LBS = 3 * MiB + 512 * 1024, WS_DEC = 4 * MiB;
constexpr size_t WS_W = 6 * MiB, W_LAYER = 42 * MiB + 512 * 1024;
constexpr size_t WO_GU1 = 0, WO_D1 = 11 * MiB, WO_IN = 16 * MiB + 512 * 1024, WO_OUT = 24 * MiB, WO_GU2 = 26 * MiB, WO_D2 = 37 * MiB;
constexpr size_t WS_XB = 176 * MiB, WS_PROJ = 208 * MiB, WS_Q1 = 328 * MiB, WS_K2T = 344 * MiB, WS_VT = 360 * MiB, WS_AM = 376 * MiB, WS_END = 384 * MiB;
static_assert(WS_W + 4 * W_LAYER <= WS_XB && WS_XB + (size_t)M * D * 2 <= WS_PROJ && WS_PROJ + (size_t)M * LD * 2 <= WS_Q1, "ws map");

constexpr int LDS_BYTES = 147456;
#ifndef ATT_TR
#define ATT_TR 1
#endif

DI float bf2f(unsigned short h) { return __uint_as_float(((unsigned)h) << 16); }
DI unsigned cvt_pk_bf16(float lo, float hi) { unsigned r; asm("v_cvt_pk_bf16_f32 %0, %1, %2" : "=v"(r) : "v"(lo), "v"(hi)); return r; }
template <int CTRL> DI float dpp_add(float v) { return v + __int_as_float(__builtin_amdgcn_update_dpp(0, __float_as_int(v), CTRL, 0xf, 0xf, false)); }
DI float row16_sum(float v) {
    v = dpp_add<0xB1>(v); v = dpp_add<0x4E>(v); v = dpp_add<0x141>(v); v = dpp_add<0x140>(v); return v;
}
DI float shfl_lane(float v, int src_lane) { return __int_as_float(__builtin_amdgcn_ds_bpermute(src_lane << 2, __float_as_int(v))); }
DI float fast_sigmoid(float x) { return __builtin_amdgcn_rcpf(1.f + __expf(-x)); }

namespace pg8 {
#define PG8_LAS __attribute__((address_space(3)))
constexpr int BM = 256, BK = 64, HALF = 128, HTB = HALF * BK * 2, STAGE_BYTES = 8 * HTB, NXCD = 8, WGM = 8;
__host__ __device__ __forceinline__ int lds_byte(int r, int c) { const int st = (r >> 4) * 2 + (c >> 5), rr = r & 15, cc = c & 31, ob = rr * 64 + cc * 2; return st * 1024 + (ob ^ (((ob >> 9) & 1) << 5)); }
__host__ __device__ __forceinline__ void stage_rc(int b, int& R, int& C) { const int st = b / 1024, sb = b % 1024, swz = sb ^ (((sb >> 9) & 1) << 5); R = (st >> 1) * 16 + swz / 64; C = (st & 1) * 32 + (swz % 64) / 2; }
__host__ __device__ __forceinline__ int perm32(int rho) { const int n = rho >> 4, i = rho & 15; return 8 * (i >> 2) + 4 * n + (i & 3); }

struct Unit { int pm, pn; };
struct Gemm { const bf16_t* A; const bf16_t* Bt; int M, N, K, lda, ldb; };

struct StaticOrder {
    int nM, nN, nwg, G, c;
    __host__ __device__ void init(int M_, int N_, int G_, int c_) { nM = M_ / BM; nN = N_ / BM; nwg = nM * nN; G = G_; c = c_; }
    __host__ __device__ bool next(int i, Unit& u) const {
        const long L = (long)i * G + c; if (L >= nwg) return false;
        int wgid = (int)L; { const int q = nwg / NXCD, r = nwg % NXCD, xcd = wgid % NXCD, off = wgid / NXCD; wgid = (xcd < r ? xcd * (q + 1) : r * (q + 1) + (xcd - r) * q) + off; }
        const int nig = WGM * nN, gid = wgid / nig, fm = gid * WGM, gsz = (nM - fm) < WGM ? (nM - fm) : WGM;
        u.pm = fm + ((wgid % nig) % gsz); u.pn = (wgid % nig) / gsz; return true;
    }
};

template <class Epi, bool ALIGN_EPI>
__device__ __forceinline__ void gemm_phase(PG8_LAS unsigned char* lds, const Gemm g, const StaticOrder& S, const Epi& E, const int tid) {
    const int wid = __builtin_amdgcn_readfirstlane(tid >> 6), lane = tid & 63, wr = wid >> 2, wc = wid & 3, fr = lane & 15, fq = lane >> 4;
    const int K = g.K, nt = K / BK;
    unsigned voffA[2], voffB[2];
#pragma unroll
    for (int i = 0; i < 2; ++i) { int R, C; stage_rc(tid * 16 + i * 8192, R, C); const int Rb = (R & ~31) + perm32(R & 31);
        voffA[i] = (unsigned)(R * g.lda + C) * 2u; voffB[i] = (unsigned)(Rb * g.ldb + C) * 2u; }
    const size_t kstep = (size_t)(BK * 2);
    const size_t hA = (size_t)HALF * g.lda * 2, hB = (size_t)HALF * g.ldb * 2, tA = 2 * hA, tB = 2 * hB;
    const unsigned ldsw = (unsigned)wid * 1024u;
    const int aoff = lds_byte(wr * 64 + fr, fq * 8), boff = lds_byte(wc * 32 + fr, fq * 8);
#define PG8_SA(b, h) (((b) * 2 + (h)) * HTB)
#define PG8_SB(b, h) ((4 + (b) * 2 + (h)) * HTB)
#define PG8_STAGE(bufoff, gbase, voff) do { _Pragma("unroll") for (int _i = 0; _i < 2; ++_i) \
        __builtin_amdgcn_global_load_lds((const unsigned*)((const char*)(gbase) + (voff)[_i]), (PG8_LAS unsigned*)(lds + (bufoff) + ldsw + _i * 8192), 16, 0, 0); } while (0)
#define PG8_LDA(dst, b, h) do { _Pragma("unroll") for (int m = 0; m < 4; ++m) _Pragma("unroll") for (int k = 0; k < 2; ++k) dst[m][k] = *(const PG8_LAS bf16x8*)(lds + PG8_SA(b, h) + aoff + m * 2048 + k * 1024); } while (0)
#define PG8_LDB(dst, b, h) do { _Pragma("unroll") for (int n = 0; n < 2; ++n) _Pragma("unroll") for (int k = 0; k < 2; ++k) dst[n][k] = *(const PG8_LAS bf16x8*)(lds + PG8_SB(b, h) + boff + n * 2048 + k * 1024); } while (0)
#define PG8_MMA(ai, bj, At, Bt) do { __builtin_amdgcn_s_setprio(1); _Pragma("unroll") for (int m = 0; m < 4; ++m) _Pragma("unroll") for (int n = 0; n < 2; ++n) _Pragma("unroll") for (int k = 0; k < 2; ++k) \
        acc[ai][bj][m][n] = __builtin_amdgcn_mfma_f32_16x16x32_bf16(Bt[n][k], At[m][k], acc[ai][bj][m][n], 0, 0, 0); __builtin_amdgcn_s_setprio(0); } while (0)
#define PG8_WAIT_V(n) asm volatile("s_waitcnt vmcnt(" #n ")" ::: "memory")
#define PG8_WAIT_L(n) asm volatile("s_waitcnt lgkmcnt(" #n ")" ::: "memory")
#define PG8_BAR __builtin_amdgcn_s_barrier()
#define PG8_SCHED __builtin_amdgcn_sched_barrier(0)
    Unit cur, nxt; int ui = 0;
    if (!S.next(0, cur)) return;
    f32x4 acc[2][2][4][2];
#pragma unroll
    for (int a = 0; a < 2; ++a)
#pragma unroll
        for (int b = 0; b < 2; ++b)
#pragma unroll
            for (int m = 0; m < 4; ++m)
#pragma unroll
                for (int n = 0; n < 2; ++n) acc[a][b][m][n] = (f32x4){0.f, 0.f, 0.f, 0.f};
    bf16x8 At[4][2], B0[2][2], B1[2][2];
    const char* cA = (const char*)g.A + (size_t)cur.pm * tA; const char* cB = (const char*)g.Bt + (size_t)cur.pn * tB;
    PG8_STAGE(PG8_SB(0, 0), cB, voffB); PG8_STAGE(PG8_SB(0, 1), cB + hB, voffB); PG8_STAGE(PG8_SA(0, 0), cA, voffA); PG8_STAGE(PG8_SA(0, 1), cA + hA, voffA);
    if (wr == 1) PG8_BAR;
    PG8_WAIT_V(2); PG8_BAR;
    PG8_STAGE(PG8_SB(1, 0), cB + kstep, voffB); PG8_STAGE(PG8_SA(1, 0), cA + kstep, voffA); PG8_STAGE(PG8_SB(1, 1), cB + hB + kstep, voffB);
    PG8_WAIT_V(6); PG8_BAR;
    for (;;) {
        const bool has_next = S.next(ui + 1, nxt);
        const char* nA = has_next ? (const char*)g.A + (size_t)nxt.pm * tA : cA; const char* nB = has_next ? (const char*)g.Bt + (size_t)nxt.pn * tB : cB;
        for (int t = 0; t < nt; t += 2) {
            const bool last = (t == nt - 2);
            const char* a1 = cA + (size_t)(t + 1) * kstep;
            const char* a2 = last ? nA : cA + (size_t)(t + 2) * kstep; const char* b2 = last ? nB : cB + (size_t)(t + 2) * kstep;
            const char* a3 = a2 + kstep; const char* b3 = b2 + kstep;
            PG8_LDB(B0, 0, 0); PG8_LDB(B1, 0, 1); PG8_SCHED; PG8_LDA(At, 0, 0); PG8_STAGE(PG8_SA(1, 1), a1 + hA, voffA);
            PG8_WAIT_V(8); PG8_WAIT_L(0); PG8_BAR; PG8_MMA(0, 0, At, B0); PG8_MMA(0, 1, At, B1); PG8_BAR; PG8_SCHED;
            PG8_LDA(At, 0, 1); PG8_STAGE(PG8_SB(0, 0), b2, voffB); PG8_STAGE(PG8_SB(0, 1), b2 + hB, voffB); PG8_STAGE(PG8_SA(0, 0), a2, voffA);
            PG8_WAIT_V(8); PG8_WAIT_L(0); PG8_BAR; PG8_MMA(1, 0, At, B0); PG8_MMA(1, 1, At, B1); PG8_BAR; PG8_SCHED;
            PG8_LDB(B0, 1, 0); PG8_LDB(B1, 1, 1); PG8_SCHED; PG8_LDA(At, 1, 0); PG8_STAGE(PG8_SA(0, 1), a2 + hA, voffA);
            PG8_WAIT_V(8); PG8_WAIT_L(0); PG8_BAR; PG8_MMA(0, 0, At, B0); PG8_MMA(0, 1, At, B1); PG8_BAR; PG8_SCHED;
            PG8_LDA(At, 1, 1); PG8_STAGE(PG8_SB(1, 0), b3, voffB); PG8_STAGE(PG8_SB(1, 1), b3 + hB, voffB); PG8_STAGE(PG8_SA(1, 0), a3, voffA);
            PG8_WAIT_V(8); PG8_WAIT_L(0); PG8_BAR; PG8_MMA(1, 0, At, B0); PG8_MMA(1, 1, At, B1); PG8_BAR; PG8_SCHED;
        }
        if constexpr (ALIGN_EPI) { if (wr == 0) PG8_BAR; }
        E(acc, cur, wr, wc, fr, fq);
        if (!has_next) break;
#pragma unroll
        for (int a = 0; a < 2; ++a)
#pragma unroll
            for (int b = 0; b < 2; ++b)
#pragma unroll
                for (int m = 0; m < 4; ++m)
#pragma unroll
                    for (int n = 0; n < 2; ++n) acc[a][b][m][n] = (f32x4){0.f, 0.f, 0.f, 0.f};
        cur = nxt; cA = nA; cB = nB; ++ui;
        if constexpr (ALIGN_EPI) { if (wr == 1) PG8_BAR; }
    }
    PG8_WAIT_V(0);
    if constexpr (!ALIGN_EPI) { if (wr == 0) PG8_BAR; }
    PG8_BAR;
#undef PG8_SA
#undef PG8_SB
#undef PG8_STAGE
#undef PG8_LDA
#undef PG8_LDB
#undef PG8_MMA
#undef PG8_WAIT_V
#undef PG8_WAIT_L
#undef PG8_BAR
#undef PG8_SCHED
}
}

DI float row_rs(const float* ssq, int row) {
    const f32x4* p = (const f32x4*)(ssq + (size_t)row * 16);
    const f32x4 a = p[0], b = p[1], c = p[2], d = p[3];
    const float s = ((a[0] + a[1]) + (a[2] + a[3])) + ((b[0] + b[1]) + (b[2] + b[3])) + ((c[0] + c[1]) + (c[2] + c[3])) + ((d[0] + d[1]) + (d[2] + d[3]));
    return __builtin_amdgcn_rsqf(s * (1.0f / D) + EPS);
}

DI void rows_rs8(const float* ssq, int row0, int fr, int fq, float (&rs)[2][4]) {
    const int lane = fr + 16 * fq;
#pragma unroll
    for (int ai = 0; ai < 2; ++ai) {
        f32x4 p[4];
#pragma unroll
        for (int m = 0; m < 4; ++m) p[m] = *(const f32x4*)(ssq + (size_t)(row0 + ai * 128 + m * 16) * 16 + 4 * fq);
#pragma unroll
        for (int m = 0; m < 4; ++m) { float s = (p[m][0] + p[m][1]) + (p[m][2] + p[m][3]); s += shfl_lane(s, lane ^ 16); s += shfl_lane(s, lane ^ 32); rs[ai][m] = __builtin_amdgcn_rsqf(s * (1.0f / D) + EPS); }
        asm volatile("" ::: "memory");
    }
}

struct EpiSwiGLU {
    bf16_t* H; const float* ssq;
    DI void operator()(const f32x4 (&acc)[2][2][4][2], const pg8::Unit& u, int wr, int wc, int fr, int fq) const {
        const int row0 = u.pm * 256 + wr * 64 + fr, col = u.pn * 128 + wc * 32 + 8 * fq;
        float rs8[2][4]; rows_rs8(ssq, u.pm * 256 + wr * 64 + fr, fr, fq, rs8);
#pragma unroll
        for (int ai = 0; ai < 2; ++ai)
#pragma unroll
            for (int m = 0; m < 4; ++m) {
                const int row = row0 + ai * 128 + m * 16; const float r = rs8[ai][m];
                float hv[8];
#pragma unroll
                for (int n = 0; n < 2; ++n)
#pragma unroll
                    for (int i = 0; i < 4; ++i) { const float gg = acc[ai][0][m][n][i] * r, uu = acc[ai][1][m][n][i] * r; hv[n * 4 + i] = gg * fast_sigmoid(gg) * uu; }
                u32x4 w; w.x = cvt_pk_bf16(hv[0], hv[1]); w.y = cvt_pk_bf16(hv[2], hv[3]); w.z = cvt_pk_bf16(hv[4], hv[5]); w.w = cvt_pk_bf16(hv[6], hv[7]);
                *(u32x4*)(H + (size_t)row * DFF + col) = w;
                asm volatile("" ::: "memory");
            }
    }
};

struct EpiResid {
    bf16_t* xb; float* ssq; float alpha;
    DI void operator()(const f32x4 (&acc)[2][2][4][2], const pg8::Unit& u, int wr, int wc, int fr, int fq) const {
        const int row0 = u.pm * 256 + wr * 64 + fr, col0 = u.pn * 256 + wc * 32 + 8 * fq;
#pragma unroll
        for (int ai = 0; ai < 2; ++ai) {
            u32x4 xw[4][2];
#pragma unroll
            for (int m = 0; m < 4; ++m)
#pragma unroll
                for (int bj = 0; bj < 2; ++bj) xw[m][bj] = *(const u32x4*)(xb + (size_t)(row0 + ai * 128 + m * 16) * D + col0 + bj * 128);
#pragma unroll
            for (int m = 0; m < 4; ++m) {
                const int row = row0 + ai * 128 + m * 16; float ss = 0.f;
#pragma unroll
                for (int bj = 0; bj < 2; ++bj) {
                    const size_t off = (size_t)row * D + col0 + bj * 128;
                    float y[8];
#pragma unroll
                    for (int q = 0; q < 4; ++q) { const unsigned wv = xw[m][bj][q]; y[2 * q] = __uint_as_float(wv << 16); y[2 * q + 1] = __uint_as_float(wv & 0xffff0000u); }
#pragma unroll
                    for (int q = 0; q < 4; ++q) { y[q] += acc[ai][bj][m][0][q] * alpha; y[4 + q] += acc[ai][bj][m][1][q] * alpha; }
                    u32x4 w; w.x = cvt_pk_bf16(y[0], y[1]); w.y = cvt_pk_bf16(y[2], y[3]); w.z = cvt_pk_bf16(y[4], y[5]); w.w = cvt_pk_bf16(y[6], y[7]);
                    *(u32x4*)(xb + off) = w;
#pragma unroll
                    for (int q = 0; q < 4; ++q) { const float a0 = __uint_as_float(w[q] << 16), a1 = __uint_as_float(w[q] & 0xffff0000u); ss += a0 * a0 + a1 * a1; }
                }
                { const int ln = fr + 16 * fq; ss += shfl_lane(ss, ln ^ 16); ss += shfl_lane(ss, ln ^ 32); }
                if (fq == 0) ssq[(size_t)row * 16 + u.pn * 4 + wc] = ss;
            }
            asm volatile("" ::: "memory");
        }
    }
};

struct EpiProj {
    bf16_t* P; const float* ssq; const float* rope; float* ffb;
    DI void operator()(const f32x4 (&acc)[2][2][4][2], const pg8::Unit& u, int wr, int wc, int fr, int fq) const {
        const int row0 = u.pm * 256 + wr * 64 + fr, colw = wc * 32 + 8 * fq;
        const bool rot = (u.pn == 1 || u.pn == 6) && ((colw & 63) < 16);
        const int ra = ((colw & 63) == 0) ? 0 : 4;
        float rs8[2][4]; rows_rs8(ssq, u.pm * 256 + wr * 64 + fr, fr, fq, rs8);
#pragma unroll
        for (int ai = 0; ai < 2; ++ai)
#pragma unroll
            for (int m = 0; m < 4; ++m) {
                const int row = row0 + ai * 128 + m * 16; const float r = rs8[ai][m];
                if (u.pn == 14) { if (wc == 0 && fq == 0) *(f32x4*)(ffb + (size_t)row * 4) = acc[ai][0][m][0] * r; continue; }
                f32x4 cs = {1.f, 1.f, 1.f, 1.f}, sn = {0.f, 0.f, 0.f, 0.f};
                if (rot) { cs = *(const f32x4*)(rope + (size_t)row * 16 + ra); sn = *(const f32x4*)(rope + (size_t)row * 16 + 8 + ra); }
#pragma unroll
                for (int bj = 0; bj < 2; ++bj) {
                    const f32x4 v0 = acc[ai][bj][m][0] * r, v1 = acc[ai][bj][m][1] * r;
                    const f32x4 o0 = v0 * cs - v1 * sn, o1 = v1 * cs + v0 * sn;
                    u32x4 w; w.x = cvt_pk_bf16(o0[0], o0[1]); w.y = cvt_pk_bf16(o0[2], o0[3]); w.z = cvt_pk_bf16(o1[0], o1[1]); w.w = cvt_pk_bf16(o1[2], o1[3]);
                    *(u32x4*)(P + (size_t)row * LD + u.pn * 256 + bj * 128 + colw) = w;
                }
                asm volatile("" ::: "memory");
            }
    }
};

DI int rope_perm(int j) { return (j >= 4 && j < 8) ? j + 4 : ((j >= 8 && j < 12) ? j - 4 : j); }
DI int win_src(int d) {
    if (d < 256) return S_FQ + d;
    if (d < 512) { const int j = d - 256; return S_DQ + (j & ~63) + rope_perm(j & 63); }
    if (d < 1024) return S_HQ + (d - 512);
    if (d < 1280) return S_FK + (d - 1024);
    if (d < 1536) return S_FV + (d - 1280);
    if (d < 1792) { const int j = d - 1536; return S_DK + (j & ~63) + rope_perm(j & 63); }
    if (d < 2048) return S_DV + (d - 1792);
    if (d < 2560) return S_HF + (d - 2048);
    if (d < 3072) return S_HI + (d - 2560);
    if (d < 3584) return S_HG + (d - 3072);
    if (d < 3588) return S_FF + (d - 3584);
    return -1;
}
DI void conv_item(const float* W, int N, int K, const float* gk, bf16_t* WT, int drow0, int mode, int src0, int kb, float* scr, int lane) {
    const int k0 = 64 * kb, n4 = (lane & 7) * 4;
    const int sc = mode == 0 ? src0 + n4 : win_src(drow0 + n4);
    f32x4 v[8];
    const float* wp = W + (size_t)(k0 + (lane >> 3)) * N + (sc >= 0 ? sc : 0);
#pragma unroll
    for (int i = 0; i < 8; ++i) v[i] = *(const f32x4*)(wp + (size_t)(8 * i) * N);
#pragma unroll
    for (int i = 0; i < 8; ++i) { float* sp = scr + (8 * i + (lane >> 3)) * 33 + n4;
        sp[0] = (sc >= 0) ? v[i][0] : 0.f; sp[1] = (sc >= 0) ? v[i][1] : 0.f; sp[2] = (sc >= 0) ? v[i][2] : 0.f; sp[3] = (sc >= 0) ? v[i][3] : 0.f; }
    asm volatile("s_waitcnt lgkmcnt(0)" ::: "memory");
    const int c = lane & 7;
    f32x4 g0 = {1.f, 1.f, 1.f, 1.f}, g1 = {1.f, 1.f, 1.f, 1.f};
    if (gk) { g0 = *(const f32x4*)(gk + k0 + 8 * c); g1 = *(const f32x4*)(gk + k0 + 8 * c + 4); }
#pragma unroll
    for (int j = 0; j < 4; ++j) { const int nn = (lane >> 3) + 8 * j; const float* s = scr + (8 * c) * 33 + nn;
        u32x4 o; o.x = cvt_pk_bf16(s[0 * 33] * g0[0], s[1 * 33] * g0[1]); o.y = cvt_pk_bf16(s[2 * 33] * g0[2], s[3 * 33] * g0[3]); o.z = cvt_pk_bf16(s[4 * 33] * g1[0], s[5 * 33] * g1[1]); o.w = cvt_pk_bf16(s[6 * 33] * g1[2], s[7 * 33] * g1[3]);
        *(u32x4*)(WT + (size_t)(drow0 + nn) * K + k0 + 8 * c) = o; }
    asm volatile("s_waitcnt lgkmcnt(0)" ::: "memory");
}

struct Args {
    const float* x; const int* pos;
    const float *f1n, *f1g, *f1u, *f1d, *mn, *win, *fb, *hlb, *hon, *wout, *f2n, *f2g, *f2u, *f2d, *fn;
    float* out; unsigned char* ws;
};

DI void sincos_d(double x, float& s, float& c) {
    const double k = __builtin_rint(x * 0.63661977236758134308);
    const double r = (x - k * 1.5707963267948966192) - k * 6.123233995736766e-17;
    const double r2 = r * r;
    double sp = r * (1.0 + r2 * (-1.0 / 6 + r2 * (1.0 / 120 + r2 * (-1.0 / 5040 + r2 * (1.0 / 362880 + r2 * (-1.0 / 39916800))))));
    double cp = 1.0 + r2 * (-0.5 + r2 * (1.0 / 24 + r2 * (-1.0 / 720 + r2 * (1.0 / 40320 + r2 * (-1.0 / 3628800 + r2 * (1.0 / 479001600))))));
    const int q = ((int)k) & 3;
    const double ss = (q == 0) ? sp : (q == 1) ? cp : (q == 2) ? -sp : -cp;
    const double cc = (q == 0) ? cp : (q == 1) ? -sp : (q == 2) ? -cp : sp;
    s = (float)ss; c = (float)cc;
}

DI void prologue(const Args& a, unsigned char* lds, int tid, int lane, int wave) {
    unsigned char* ws = a.ws;
    const int gw = blockIdx.x * 8 + wave, NGW = gridDim.x * 8;
    float* scr = (float*)(lds + wave * 16384);
    constexpr int I_GU = 16 * (NGU / 32), I_D = (DFF / 64) * (D / 32), I_IN = 16 * (LD / 32), I_OUT = 16 * (D / 32);
    constexpr int I_LAYER = 2 * I_GU + 2 * I_D + I_IN + I_OUT;
    for (int it = gw; it < DEPTH * I_LAYER; it += NGW) {
        const int l = it / I_LAYER; int r = it % I_LAYER;
        unsigned char* wl = ws + WS_W + (size_t)l * W_LAYER;
        if (r < 2 * I_GU) {
            const int f = r >= I_GU; if (f) r -= I_GU;
            const int rb = r >> 4, kb = r & 15, d0 = rb * 32, pn = d0 >> 8, within = d0 & 255;
            const float* Wg = (f ? a.f2g : a.f1g) + (size_t)l * D * DFF; const float* Wu = (f ? a.f2u : a.f1u) + (size_t)l * D * DFF;
            const float* gk = (f ? a.f2n : a.f1n) + (size_t)l * D;
            conv_item(within < 128 ? Wg : Wu, DFF, D, gk, (bf16_t*)(wl + (f ? WO_GU2 : WO_GU1)), d0, 0, 128 * pn + (within & 127), kb, scr, lane);
            continue;
        }
        r -= 2 * I_GU;
        if (r < 2 * I_D) {
            const int f = r >= I_D; if (f) r -= I_D;
            const int rb = r / (DFF / 64), kb = r % (DFF / 64);
            conv_item((f ? a.f2d : a.f1d) + (size_t)l * DFF * D, D, DFF, nullptr, (bf16_t*)(wl + (f ? WO_D2 : WO_D1)), rb * 32, 0, rb * 32, kb, scr, lane);
            continue;
        }
        r -= 2 * I_D;
        if (r < I_IN) { const int rb = r >> 4, kb = r & 15;
            conv_item(a.win + (size_t)l * D * NIN, NIN, D, a.mn + (size_t)l * D, (bf16_t*)(wl + WO_IN), rb * 32, 1, 0, kb, scr, lane); continue; }
        r -= I_IN;
        { const int rb = r >> 4, kb = r & 15; conv_item(a.wout + (size_t)l * D * D, D, D, nullptr, (bf16_t*)(wl + WO_OUT), rb * 32, 0, rb * 32, kb, scr, lane); }
    }
    bf16_t* xb = (bf16_t*)(ws + WS_XB); float* ssq = (float*)(ws + WS_SSQ);
    for (int m = gw; m < M; m += NGW) {
        const f32x4* xr = (const f32x4*)(a.x + (size_t)m * D) + lane; float s = 0.f;
        u32x2* o8 = (u32x2*)(xb + (size_t)m * D) + lane;
#pragma unroll
        for (int j = 0; j < 4; ++j) { const f32x4 v = xr[64 * j]; u32x2 w; w.x = cvt_pk_bf16(v[0], v[1]); w.y = cvt_pk_bf16(v[2], v[3]); o8[64 * j] = w;
            const float a0 = __uint_as_float(w.x << 16), a1 = __uint_as_float(w.x & 0xffff0000u), a2 = __uint_as_float(w.y << 16), a3 = __uint_as_float(w.y & 0xffff0000u); s += (a0 * a0 + a1 * a1) + (a2 * a2 + a3 * a3); }
#pragma unroll
        for (int o = 1; o < 64; o <<= 1) s += __shfl_xor(s, o);
        if (lane < 16) ssq[(size_t)m * 16 + lane] = lane == 0 ? s : 0.f;
    }
    float* rope = (float*)(ws + WS_ROPE);
    for (int i = blockIdx.x * 512 + tid; i < M * 8; i += gridDim.x * 512) {
        const int m = i >> 3, fi = i & 7;
        const float freq = exp2f(-(float)fi * 0.125f * 18.931568569324174f);
        const float ang = (float)a.pos[m] * freq;
        float s, c; sincos_d((double)ang, s, c);
        rope[(size_t)m * 16 + fi] = c; rope[(size_t)m * 16 + 8 + fi] = s;
    }
    if (blockIdx.x == 0) {
        float* lbs = (float*)(ws + WS_LBS); const int j = tid;
        float v[DEPTH], mx = -1e30f, sum = 0.f;
#pragma unroll
        for (int l = 0; l < DEPTH; ++l) { v[l] = a.hlb[l * 512 + j]; mx = fmaxf(mx, v[l]); }
#pragma unroll
        for (int l = 0; l < DEPTH; ++l) { v[l] = expf(v[l] - mx); sum += v[l]; }
        float run = 0.f;
#pragma unroll
        for (int l = 0; l < DEPTH; ++l) { if (l > 0) run += v[l] / sum; lbs[l * 512 + j] = fminf(fmaxf(run, 0.f), 1.0f - 1e-6f); }
    }
}

DI float log_sigmoid(float z) { return fminf(z, 0.f) - __logf(1.f + __expf(-fabsf(z))); }

DI void fox_scan(const Args& a, int layer, int bh, unsigned char* lds, int tid, int lane, int wave) {
    const int b = bh >> 2, h = bh & 3;
    const float* ffb = (const float*)(a.ws + WS_FFB); float* carr = (float*)(a.ws + WS_CARR) + (size_t)bh * T;
    const float bias = a.fb[layer * 4 + h];
    float v[4], run = 0.f;
#pragma unroll
    for (int j = 0; j < 4; ++j) { const int t = tid * 4 + j; run += log_sigmoid(ffb[(size_t)(b * T + t) * 4 + h] + bias); v[j] = run; }
    float inc = run;
#pragma unroll
    for (int o = 1; o < 64; o <<= 1) { const float up = shfl_lane(inc, (lane - o) & 63); if (lane >= o) inc += up; }
    float* wt = (float*)lds;
    if (lane == 63) wt[wave] = inc;
    __syncthreads();
    float pre = inc - run;
    for (int w = 0; w < wave; ++w) pre += wt[w];
    f32x4 o = {v[0] + pre, v[1] + pre, v[2] + pre, v[3] + pre};
    *(f32x4*)(carr + tid * 4) = o;
    __syncthreads();
}

DI void hgrn_prep(const Args& a, int layer, int item, unsigned char* lds, int tid, int lane, int wave) {
    const int bh = item >> 5, c = item & 31, b = bh >> 2, h = bh & 3, m0 = b * T + c * 64;
    const bf16_t* P = (const bf16_t*)(a.ws + WS_PROJ) + (size_t)m0 * LD;
    bf16_t* Q1 = (bf16_t*)(a.ws + WS_Q1) + (size_t)item * 8192; bf16_t* K2T = (bf16_t*)(a.ws + WS_K2T) + (size_t)item * 8192;
    bf16_t* VT = (bf16_t*)(a.ws + WS_VT) + (size_t)item * 8192; bf16_t* AM = (bf16_t*)(a.ws + WS_AM) + (size_t)item * 4096;
    float* DEC = (float*)(a.ws + WS_DEC) + (size_t)item * 128;
    bf16_t* qmL = (bf16_t*)lds; bf16_t* kmL = (bf16_t*)(lds + 17408); float* tot = (float*)(lds + 34816);
    bf16_t* zL = (bf16_t*)(lds + 36864); bf16_t* hqL = (bf16_t*)(lds + 36864 + 16384); bf16_t* hiL = (bf16_t*)(lds + 36864 + 32768);
    { u32x4 t[6];
#pragma unroll
      for (int j = 0; j < 2; ++j) { const int ci = tid + 512 * j, row = ci >> 4, c16 = ci & 15; const bf16_t* rp = P + (size_t)row * LD + h * 128 + c16 * 8;
          t[j] = *(const u32x4*)(rp + C_HF); t[2 + j] = *(const u32x4*)(rp + C_HQ); t[4 + j] = *(const u32x4*)(rp + C_HI); }
#pragma unroll
      for (int j = 0; j < 2; ++j) { const int ci = tid + 512 * j; *(u32x4*)(zL + ci * 8) = t[j]; *(u32x4*)(hqL + ci * 8) = t[2 + j]; *(u32x4*)(hiL + ci * 8) = t[4 + j]; } }
    __syncthreads();
    const int e = tid & 127, qd = tid >> 7;
    const float lb = ((const float*)(a.ws + WS_LBS))[layer * 512 + h * 128 + e];
    const float la = __logf(fmaxf(lb, 1e-30f)), l1 = log1pf(-lb), oml = 1.f - lb;
    float bl[16], kq[16], qq[16]; float run = 0.f;
#pragma unroll
    for (int j = 0; j < 16; ++j) {
        const int s = 16 * qd + j;
        const float z = bf2f(zL[s * 128 + e]);
        const float ez = __expf(-fabsf(z)), lsz = fminf(z, 0.f) - __logf(1.f + ez);
        const float b2 = l1 + lsz, mx = fmaxf(la, b2), lf = mx + __logf(1.f + __expf(-fabsf(la - b2)));
        run += lf; bl[j] = run;
        const float rc = __builtin_amdgcn_rcpf(1.f + ez);
        kq[j] = oml * (z >= 0.f ? ez * rc : rc);
        const float hq = bf2f(hqL[s * 128 + e]);
        qq[j] = hq * fast_sigmoid(hq);
    }
    tot[qd * 128 + e] = run;
    __syncthreads();
    const float t0 = tot[e], t1 = tot[128 + e], t2 = tot[256 + e], t3 = tot[384 + e];
    const float off = (qd > 0 ? t0 : 0.f) + (qd > 1 ? t1 : 0.f) + (qd > 2 ? t2 : 0.f);
    const float blast = ((t0 + t1) + t2) + t3, rmid = t0 + t1;
    unsigned k2p[8]; float k2prev = 0.f;
#pragma unroll
    for (int j = 0; j < 16; ++j) {
        const int s = 16 * qd + j; const float bb = bl[j] + off;
        const float q1 = qq[j] * __expf(bb), qm = qq[j] * __expf(fminf(bb - rmid, 80.f)), km = kq[j] * __expf(fminf(rmid - bb, 80.f)), k2 = kq[j] * __expf(blast - bb);
        Q1[s * 128 + e] = (bf16_t)(cvt_pk_bf16(q1, 0.f) & 0xffffu);
        qmL[s * 136 + e] = (bf16_t)(cvt_pk_bf16(qm, 0.f) & 0xffffu);
        kmL[s * 136 + e] = (bf16_t)(cvt_pk_bf16(km, 0.f) & 0xffffu);
        if (j & 1) k2p[j >> 1] = cvt_pk_bf16(k2prev, k2); else k2prev = k2;
    }
    { u32x4 w0 = {k2p[0], k2p[1], k2p[2], k2p[3]}, w1 = {k2p[4], k2p[5], k2p[6], k2p[7]};
      *(u32x4*)(K2T + e * 64 + 16 * qd) = w0; *(u32x4*)(K2T + e * 64 + 16 * qd + 8) = w1; }
    if (qd == 0) DEC[e] = __expf(blast);
    { unsigned vp[8]; unsigned prev = 0;
#pragma unroll
      for (int j = 0; j < 16; ++j) { const unsigned hv = hiL[(16 * qd + j) * 128 + e]; if (j & 1) vp[j >> 1] = prev | (hv << 16); else prev = hv; }
      u32x4 w0 = {vp[0], vp[1], vp[2], vp[3]}, w1 = {vp[4], vp[5], vp[6], vp[7]};
      *(u32x4*)(VT + e * 64 + 16 * qd) = w0; *(u32x4*)(VT + e * 64 + 16 * qd + 8) = w1; }
    __syncthreads();
    const int r = lane & 15, g = lane >> 4;
#pragma unroll
    for (int q = 0; q < 2; ++q) {
        const int id = 2 * wave + q, tt = id >> 2, st = id & 3;
        f32x4 acc = {0.f, 0.f, 0.f, 0.f};
        if (st <= tt) {
#pragma unroll
            for (int kk = 0; kk < 4; ++kk) {
                const bf16x8 av = *(const bf16x8*)(qmL + (16 * tt + r) * 136 + 32 * kk + 8 * g);
                const bf16x8 bv = *(const bf16x8*)(kmL + (16 * st + r) * 136 + 32 * kk + 8 * g);
                acc = __builtin_amdgcn_mfma_f32_16x16x32_bf16(av, bv, acc, 0, 0, 0);
            }
        }
#pragma unroll
        for (int i = 0; i < 4; ++i) { const int t = 16 * tt + 4 * g + i, s = 16 * st + r; const float val = (s <= t) ? acc[i] : 0.f;
            AM[t * 64 + s] = (bf16_t)(cvt_pk_bf16(val, 0.f) & 0xffffu); }
    }
    __syncthreads();
}

constexpr int CH_Q1 = 0, CH_AM = 18432, CH_K2 = 28672, CH_DEC = 49152, CH_BUF = 50176, CH_PART = 2 * CH_BUF;
struct ChainRegs { u32x4 q[2], k[2], am, dc; bf16x8 vf[2]; };
DI void chain_fetch(const Args& a, int item, int tid, int w, int r, int g, ChainRegs& R) {
    const bf16_t* __restrict__ q1 = (const bf16_t*)(a.ws + WS_Q1) + (size_t)item * 8192; const bf16_t* __restrict__ k2t = (const bf16_t*)(a.ws + WS_K2T) + (size_t)item * 8192;
    const bf16_t* __restrict__ vt = (const bf16_t*)(a.ws + WS_VT) + (size_t)item * 8192; const bf16_t* __restrict__ am = (const bf16_t*)(a.ws + WS_AM) + (size_t)item * 4096;
    const float* __restrict__ dec = (const float*)(a.ws + WS_DEC) + (size_t)item * 128;
#pragma unroll
    for (int j = 0; j < 2; ++j) { R.q[j] = *(const u32x4*)(q1 + (tid + 512 * j) * 8); R.k[j] = *(const u32x4*)(k2t + (tid + 512 * j) * 8); }
    R.am = *(const u32x4*)(am + tid * 8);
    R.dc = *(const u32x4*)(dec + (tid & 31) * 4);
#pragma unroll
    for (int ks = 0; ks < 2; ++ks) R.vf[ks] = *(const bf16x8*)(vt + (16 * w + r) * 64 + 32 * ks + 8 * g);
}
DI void chain_stash(unsigned char* buf, int tid, const ChainRegs& R) {
#pragma unroll
    for (int j = 0; j < 2; ++j) {
        const int ci = tid + 512 * j;
        *(u32x4*)(buf + CH_Q1 + (ci >> 4) * 288 + (ci & 15) * 16) = R.q[j];
        const int e = ci >> 3, wi = e & 31, row = 16 * (2 * (e >> 5) + ((wi >> 2) & 1)) + 4 * (wi >> 3) + (wi & 3);
        *(u32x4*)(buf + CH_K2 + row * 160 + (ci & 7) * 16) = R.k[j];
    }
    *(u32x4*)(buf + CH_AM + (tid >> 3) * 160 + (tid & 7) * 16) = R.am;
    if (tid < 32) *(u32x4*)(buf + CH_DEC + tid * 16) = R.dc;
}
DI void hgrn_chain(const Args& a, int layer, int bh, unsigned char* lds, int tid, int lane, int wave) {
    const int b = bh >> 2, h = bh & 3, r = lane & 15, g = lane >> 4, w = wave;
    const bf16_t* __restrict__ Pg = (const bf16_t*)(a.ws + WS_PROJ) + C_HG + h * 128 + 16 * w + r;
    bf16_t* __restrict__ Po = (bf16_t*)(a.ws + WS_PROJ) + C_HQ + h * 128 + 16 * w + r;
    float* part = (float*)(lds + CH_PART);
    const float nw = a.hon[layer * 512 + h * 128 + 16 * w + r];
    f32x4 S[4][2];
#pragma unroll
    for (int eb = 0; eb < 4; ++eb) { S[eb][0] = (f32x4){0.f, 0.f, 0.f, 0.f}; S[eb][1] = (f32x4){0.f, 0.f, 0.f, 0.f}; }
    ChainRegs R;
    chain_fetch(a, bh * 32, tid, w, r, g, R);
    chain_stash(lds, tid, R);
    bf16x8 vf[2] = {R.vf[0], R.vf[1]};
    asm volatile("" : "+v"(vf[0]), "+v"(vf[1]));
    chain_fetch(a, bh * 32 + 1, tid, w, r, g, R);
    __syncthreads();
#define CH_SCHED __builtin_amdgcn_sched_barrier(0)
#pragma unroll 1
    for (int c = 0; c < 32; ++c) {
        const int m0 = b * T + c * 64;
        const unsigned char* buf = lds + (c & 1) * CH_BUF;
        unsigned short gt[4][4];
#pragma unroll
        for (int tt = 0; tt < 4; ++tt)
#pragma unroll
            for (int i = 0; i < 4; ++i) gt[tt][i] = Pg[(size_t)(m0 + 16 * tt + 4 * g + i) * LD];
        bf16x8 sb[4];
#pragma unroll
        for (int eb = 0; eb < 4; ++eb) {
            u32x4 t; t.x = cvt_pk_bf16(S[eb][0][0], S[eb][0][1]); t.y = cvt_pk_bf16(S[eb][0][2], S[eb][0][3]); t.z = cvt_pk_bf16(S[eb][1][0], S[eb][1][1]); t.w = cvt_pk_bf16(S[eb][1][2], S[eb][1][3]);
            sb[eb] = __builtin_bit_cast(bf16x8, t);
        }
        f32x4 o[4]; bf16x8 fa[2][6];
#define CH_LOADF(tt, dst) do { _Pragma("unroll") for (int eb = 0; eb < 4; ++eb) dst[eb] = *(const bf16x8*)(buf + CH_Q1 + (16 * (tt) + r) * 288 + (32 * eb + 8 * g) * 2); \
                               _Pragma("unroll") for (int ks = 0; ks < 2; ++ks) dst[4 + ks] = *(const bf16x8*)(buf + CH_AM + (16 * (tt) + r) * 160 + (32 * ks + 8 * g) * 2); } while (0)
        CH_LOADF(0, fa[0]);
#pragma unroll
        for (int tt = 0; tt < 4; ++tt) {
            if (tt < 3) CH_LOADF(tt + 1, fa[(tt + 1) & 1]);
            CH_SCHED;
            o[tt] = (f32x4){0.f, 0.f, 0.f, 0.f};
#pragma unroll
            for (int eb = 0; eb < 4; ++eb) o[tt] = __builtin_amdgcn_mfma_f32_16x16x32_bf16(fa[tt & 1][eb], sb[eb], o[tt], 0, 0, 0);
#pragma unroll
            for (int ks = 0; ks < 2; ++ks) o[tt] = __builtin_amdgcn_mfma_f32_16x16x32_bf16(fa[tt & 1][4 + ks], vf[ks], o[tt], 0, 0, 0);
            CH_SCHED;
        }
        bf16x8 fk[2][4]; f32x4 fd[2][2];
#define CH_LOADK(eb, dk, dd) do { _Pragma("unroll") for (int hh = 0; hh < 2; ++hh) { dd[hh] = *(const f32x4*)(buf + CH_DEC + (32 * (eb) + 8 * g + 4 * hh) * 4); \
                               _Pragma("unroll") for (int ks = 0; ks < 2; ++ks) dk[2 * hh + ks] = *(const bf16x8*)(buf + CH_K2 + (16 * (2 * (eb) + hh) + r) * 160 + (32 * ks + 8 * g) * 2); } } while (0)
        CH_LOADK(0, fk[0], fd[0]);
#pragma unroll
        for (int eb = 0; eb < 4; ++eb) {
            if (eb < 3) CH_LOADK(eb + 1, fk[(eb + 1) & 1], fd[(eb + 1) & 1]);
            CH_SCHED;
#pragma unroll
            for (int hh = 0; hh < 2; ++hh) {
                S[eb][hh] = S[eb][hh] * fd[eb & 1][hh];
#pragma unroll
                for (int ks = 0; ks < 2; ++ks) S[eb][hh] = __builtin_amdgcn_mfma_f32_16x16x32_bf16(fk[eb & 1][2 * hh + ks], vf[ks], S[eb][hh], 0, 0, 0);
            }
            CH_SCHED;
        }
        float* pb = part + (c & 1) * 512;
#pragma unroll
        for (int tt = 0; tt < 4; ++tt) {
            f32x4 sq = o[tt] * o[tt];
#pragma unroll
            for (int i = 0; i < 4; ++i) sq[i] = row16_sum(sq[i]);
            if (r == 0) *(f32x4*)(pb + w * 64 + 16 * tt + 4 * g) = sq;
        }
        chain_stash(lds + ((c + 1) & 1) * CH_BUF, tid, R);
        vf[0] = R.vf[0]; vf[1] = R.vf[1];
        asm volatile("" : "+v"(vf[0]), "+v"(vf[1]));
        chain_fetch(a, bh * 32 + (c < 30 ? c + 2 : 31), tid, w, r, g, R);
        __syncthreads();
#pragma unroll
        for (int tt = 0; tt < 4; ++tt) {
            const f32x4 tot = *(const f32x4*)(pb + (r & 7) * 64 + 16 * tt + 4 * g);
#pragma unroll
            for (int i = 0; i < 4; ++i) {
                const int t = 16 * tt + 4 * g + i; const float rs = __builtin_amdgcn_rsqf(row16_sum(tot[i]) * (0.5f / 128.f) + EPS);
                const float val = o[tt][i] * rs * nw * fast_sigmoid(bf2f(gt[tt][i]));
                Po[(size_t)(m0 + t) * LD] = (bf16_t)(cvt_pk_bf16(val, 0.f) & 0xffffu);
            }
        }
    }
#undef CH_LOADF
#undef CH_LOADK
#undef CH_SCHED
    __syncthreads();
}

typedef short s16x4 __attribute__((ext_vector_type(4)));
struct AttnState { float l[2]; f32x4 O[2][4]; };
struct AttnTile { bf16x8 kf[2][2]; u32x4 vv[4]; f32x4 c0, c1; };
constexpr float LOG2E = 1.4426950408889634f;
template <int MODE>
DI void attn_load(const bf16_t* P, const float* cb, int mb, int kcol, int vcol, int kb0, int ks, int j, int lane, AttnTile& t) {
    const int r = lane & 15, g = lane >> 4, sb0 = 32 * j;
#pragma unroll
    for (int h2 = 0; h2 < 2; ++h2) {
        int tk = kb0 + (sb0 + 8 * (r >> 2) + 4 * h2 + (r & 3)) * ks; tk = tk < 0 ? 0 : (tk > T - 1 ? T - 1 : tk);
        const bf16_t* kp = P + (size_t)(mb + tk) * LD + kcol + 8 * g;
        t.kf[h2][0] = *(const bf16x8*)kp; t.kf[h2][1] = *(const bf16x8*)(kp + 32);
    }
#pragma unroll
    for (int q4 = 0; q4 < 4; ++q4) {
        int tk = kb0 + (sb0 + 8 * q4 + (lane >> 3)) * ks; tk = tk < 0 ? 0 : (tk > T - 1 ? T - 1 : tk);
        t.vv[q4] = *(const u32x4*)(P + (size_t)(mb + tk) * LD + vcol + 8 * (lane & 7));
    }
    if (MODE == 0) { t.c0 = *(const f32x4*)(cb + sb0 + 8 * g); t.c1 = *(const f32x4*)(cb + sb0 + 8 * g + 4); }
}
template <int MODE, bool MASKED>
DI void attn_qtile(const AttnTile& cu, const bf16x8 (&qf)[2], const bf16x8 (&vt)[4], float cq, int tq, int kb0, int ks, int sb0, int g, float& l, f32x4 (&O)[4]) {
    f32x4 s[2];
#pragma unroll
    for (int h2 = 0; h2 < 2; ++h2) { s[h2] = __builtin_amdgcn_mfma_f32_16x16x32_bf16(cu.kf[h2][0], qf[0], (f32x4){0.f, 0.f, 0.f, 0.f}, 0, 0, 0); s[h2] = __builtin_amdgcn_mfma_f32_16x16x32_bf16(cu.kf[h2][1], qf[1], s[h2], 0, 0, 0); }
    float p[8], ps = 0.f;
#pragma unroll
    for (int idx = 0; idx < 8; ++idx) {
        float v = s[idx >> 2][idx & 3] * (0.125f * LOG2E);
        if (MODE == 0) v += (cq - (idx < 4 ? cu.c0[idx & 3] : cu.c1[idx & 3])) * LOG2E;
        float e = __builtin_amdgcn_exp2f(fminf(v, 115.f));
        if (MASKED) {
            const int tk = kb0 + (sb0 + 8 * g + idx) * ks;
            const bool ok = (MODE == 0) ? (tk <= tq) : ((tk >= 0) && (tk <= tq) && (tq - tk <= 128 * ks));
            e = ok ? e : 0.f;
        }
        p[idx] = e; ps += e;
    }
    l += ps;
    u32x4 pw; pw.x = cvt_pk_bf16(p[0], p[1]); pw.y = cvt_pk_bf16(p[2], p[3]); pw.z = cvt_pk_bf16(p[4], p[5]); pw.w = cvt_pk_bf16(p[6], p[7]);
    const bf16x8 pf = __builtin_bit_cast(bf16x8, pw);
#pragma unroll
    for (int db = 0; db < 4; ++db) O[db] = __builtin_amdgcn_mfma_f32_16x16x32_bf16(vt[db], pf, O[db], 0, 0, 0);
}
template <int MODE>
DI void attn_seg(const bf16_t* P, const float* cb, int mb, int q0, int qs, int kcol, int vcol, int kb0, int ks, int jlo, int nt, const bf16x8 (&qf)[2][2], const float (&cq)[2], AttnState& st, unsigned char* vl, int lane) {
    const int r = lane & 15, g = lane >> 4;
    if (jlo >= nt) return;
    AttnTile nx;
    attn_load<MODE>(P, cb, mb, kcol, vcol, kb0, ks, jlo, lane, nx);
#pragma unroll 1
    for (int j = jlo; j < nt; ++j) {
        const int sb0 = 32 * j;
        AttnTile cu = nx;
        if (j + 1 < nt) attn_load<MODE>(P, cb, mb, kcol, vcol, kb0, ks, j + 1, lane, nx);
#pragma unroll
        for (int q4 = 0; q4 < 4; ++q4) *(u32x4*)(vl + (8 * q4 + (lane >> 3)) * 144 + (lane & 7) * 16) = cu.vv[q4];
        bf16x8 vt[4];
        {
            s16x4 lo0, lo1, lo2, lo3, hi0, hi1, hi2, hi3;
            const unsigned ad = (unsigned)(uintptr_t)(vl + (8 * g + (r >> 2)) * 144 + (r & 3) * 8);
            asm volatile("s_waitcnt lgkmcnt(0)\n\t"
                         "ds_read_b64_tr_b16 %0, %8\n\tds_read_b64_tr_b16 %1, %8 offset:32\n\tds_read_b64_tr_b16 %2, %8 offset:64\n\tds_read_b64_tr_b16 %3, %8 offset:96\n\t"
                         "ds_read_b64_tr_b16 %4, %8 offset:576\n\tds_read_b64_tr_b16 %5, %8 offset:608\n\tds_read_b64_tr_b16 %6, %8 offset:640\n\tds_read_b64_tr_b16 %7, %8 offset:672\n\t"
                         "s_waitcnt lgkmcnt(0)"
                         : "=&v"(lo0), "=&v"(lo1), "=&v"(lo2), "=&v"(lo3), "=&v"(hi0), "=&v"(hi1), "=&v"(hi2), "=&v"(hi3) : "v"(ad) : "memory");
            vt[0] = __builtin_shufflevector(lo0, hi0, 0, 1, 2, 3, 4, 5, 6, 7); vt[1] = __builtin_shufflevector(lo1, hi1, 0, 1, 2, 3, 4, 5, 6, 7);
            vt[2] = __builtin_shufflevector(lo2, hi2, 0, 1, 2, 3, 4, 5, 6, 7); vt[3] = __builtin_shufflevector(lo3, hi3, 0, 1, 2, 3, 4, 5, 6, 7);
        }
#pragma unroll
        for (int qi = 0; qi < 2; ++qi) {
            const int tq = q0 + (16 * qi + r) * qs;
            const int tqmin = q0 + 16 * qi * qs, tqmax = tqmin + 15 * qs, tklo = kb0 + sb0 * ks, tkhi = tklo + 31 * ks;
            bool interior;
            if (MODE == 0) interior = tkhi <= tqmin;
            else {
                if (tkhi < tqmin - 128 * ks || tklo > tqmax) continue;
                interior = (tklo >= 0) && (tklo >= tqmax - 128 * ks) && (tkhi <= tqmin);
            }
            if (interior) attn_qtile<MODE, false>(cu, qf[qi], vt, cq[qi], tq, kb0, ks, sb0, g, st.l[qi], st.O[qi]);
            else attn_qtile<MODE, true>(cu, qf[qi], vt, cq[qi], tq, kb0, ks, sb0, g, st.l[qi], st.O[qi]);
        }
    }
}

DI void attn_item(const Args& a, int x, int idx, unsigned char* vl, int lane) {
    bf16_t* P = (bf16_t*)(a.ws + WS_PROJ);
    const int r = lane & 15, g = lane >> 4;
    const bool fox = idx < 256;
    int bh, q0, qs;
    if (fox) { bh = 4 * x + (idx & 3); q0 = 32 * (63 - (idx >> 2)); qs = 1; }
    else { const int i = idx - 256; bh = 4 * x + (i & 3); const int rest = i >> 2; q0 = 512 * (rest >> 4) + (rest & 15); qs = 16; }
    const int b = bh >> 2, h = bh & 3, mb = b * T;
    const int qcol = (fox ? C_FQ : C_DQ) + h * 64;
    bf16x8 qf[2][2];
#pragma unroll
    for (int qi = 0; qi < 2; ++qi) { const bf16_t* qp = P + (size_t)(mb + q0 + (16 * qi + r) * qs) * LD + qcol + 8 * g; qf[qi][0] = *(const bf16x8*)qp; qf[qi][1] = *(const bf16x8*)(qp + 32); }
    AttnState st; float cq[2] = {0.f, 0.f};
#pragma unroll
    for (int qi = 0; qi < 2; ++qi) { st.l[qi] = 0.f;
#pragma unroll
        for (int db = 0; db < 4; ++db) st.O[qi][db] = (f32x4){0.f, 0.f, 0.f, 0.f}; }
    if (fox) {
        const float* cb = (const float*)(a.ws + WS_CARR) + (size_t)bh * T;
        cq[0] = cb[q0 + r]; cq[1] = cb[q0 + 16 + r];
        attn_seg<0>(P, cb, mb, q0, 1, C_FK + h * 64, C_FV + h * 64, 0, 1, 0, (q0 >> 5) + 1, qf, cq, st, vl, lane);
    } else {
        const int kcol = C_DK + h * 64, vcol = C_DV + h * 64;
#pragma unroll 1
        for (int br = 0; br < 3; ++br) {
            const int ks = br == 0 ? 1 : (br == 1 ? 4 : 16), nt = br == 0 ? 20 : (br == 1 ? 8 : 5);
            const int kb0 = q0 - 128 * ks;
            const int fv = kb0 >= 0 ? 0 : (-kb0 + ks - 1) / ks;
            attn_seg<1>(P, nullptr, mb, q0, 16, kcol, vcol, kb0, ks, fv >> 5, nt, qf, cq, st, vl, lane);
        }
    }
#pragma unroll
    for (int qi = 0; qi < 2; ++qi) {
        float lt = st.l[qi]; lt += shfl_lane(lt, lane ^ 16); lt += shfl_lane(lt, lane ^ 32);
        const float inv = 1.0f / lt;
        bf16_t* op = P + (size_t)(mb + q0 + (16 * qi + r) * qs) * LD + qcol + 4 * g;
#pragma unroll
        for (int db = 0; db < 4; ++db) { u32x2 w; w.x = cvt_pk_bf16(st.O[qi][db][0] * inv, st.O[qi][db][1] * inv); w.y = cvt_pk_bf16(st.O[qi][db][2] * inv, st.O[qi][db][3] * inv); *(u32x2*)(op + 16 * db) = w; }
    }
}


#define XB_TMO      128
#define XB_XCNT(j)  (256  + 64 * (j))
#define XB_XSUB(j)  (1280 + 64 * (j))
#define XB_XGEN(j)  (2304 + 64 * (j))
#define XB_TOP      3328
#define XB_TOPGEN   3392
#define XCD_BAR_WORDS 3456
#define XB_SPIN_CAP (1u << 22)
DI unsigned xb_ld(unsigned* p)              { return __hip_atomic_load(p, __ATOMIC_RELAXED, __HIP_MEMORY_SCOPE_AGENT); }
DI unsigned xb_add(unsigned* p, unsigned v) { return __hip_atomic_fetch_add(p, v, __ATOMIC_RELAXED, __HIP_MEMORY_SCOPE_AGENT); }
DI unsigned xb_xcc_id() { return (unsigned)__builtin_amdgcn_s_getreg((3 << 11) | 20) & 0xFu; }
#define XB_SPIN(cond, bar) do { unsigned _sp = 0; while (cond) { __builtin_amdgcn_s_sleep(1); \
    if ((++_sp & 255u) == 0u) { if (xb_ld(&(bar)[XB_TMO])) break; if (_sp > XB_SPIN_CAP) { atomicAdd(&(bar)[XB_TMO], 1u); break; } } } } while (0)
DI void xcd_barrier_complete(unsigned* bar, unsigned x, unsigned& nloc, unsigned& nx) {
    const unsigned G = gridDim.x * gridDim.y * gridDim.z;
    unsigned sum, cnt, mine, sp = 0u;
    for (;;) {
        sum = 0u; cnt = 0u; mine = 0u;
#pragma unroll
        for (unsigned j = 0; j < 16; ++j) { const unsigned c = xb_ld(&bar[XB_XCNT(j)]); sum += c; cnt += (c > 0u) ? 1u : 0u; mine = (j == x) ? c : mine; }
        if (sum == G) break;
        __builtin_amdgcn_s_sleep(1);
        if ((++sp & 255u) == 0u) { if (xb_ld(&bar[XB_TMO])) break; if (sp > XB_SPIN_CAP) { atomicAdd(&bar[XB_TMO], 1u); break; } }
    }
    nloc = mine > 0u ? mine : 1u; nx = cnt > 0u ? cnt : 1u;
}
DI void xcd_barrier(unsigned* bar, volatile PG8_LAS unsigned* st) {
    asm volatile("s_waitcnt vmcnt(0)" ::: "memory");
    __syncthreads();
    if (threadIdx.x == 0) {
        const unsigned x = xb_xcc_id();
        __builtin_amdgcn_s_waitcnt(0);
        unsigned nloc = st[0], nx = st[1];
        if (nloc == 0u) { xcd_barrier_complete(bar, x, nloc, nx); st[0] = nloc; st[1] = nx; }
        const unsigned old = xb_add(&bar[XB_XSUB(x)], 1u);
        const unsigned gen = old / nloc;
        if (old + 1u == (gen + 1u) * nloc) {
            __builtin_amdgcn_fence(__ATOMIC_RELEASE, "agent");
            asm volatile("s_waitcnt vmcnt(0)" ::: "memory");
            const unsigned og = xb_add(&bar[XB_TOP], 1u);
            const unsigned tg = og / nx;
            if (og + 1u == (tg + 1u) * nx) xb_add(&bar[XB_TOPGEN], 1u);
            else XB_SPIN(xb_ld(&bar[XB_TOPGEN]) == tg, bar);
            __builtin_amdgcn_fence(__ATOMIC_ACQUIRE, "agent");
            xb_add(&bar[XB_XGEN(x)], 1u);
            asm volatile("s_waitcnt vmcnt(0)" ::: "memory");
        } else {
            XB_SPIN(xb_ld(&bar[XB_XGEN(x)]) == gen, bar);
            __builtin_amdgcn_fence(__ATOMIC_ACQUIRE, "agent");
            asm volatile("s_waitcnt vmcnt(0)" ::: "memory");
        }
    }
    __syncthreads();
}

__global__ void __launch_bounds__(512, 2) fwd_megakernel(Args a) {
    extern __shared__ __attribute__((aligned(16))) unsigned char lds[];
    cg::grid_group grid = cg::this_grid();
    const int tid = threadIdx.x, lane = tid & 63, wave = __builtin_amdgcn_readfirstlane(tid >> 6);
    const int G = gridDim.x;
    const int wave_s = __builtin_amdgcn_readfirstlane(threadIdx.x >> 6);
    constexpr int BAR_WORD0 = 4096, LDS_MISC = 132096;
    if (threadIdx.x == 0) { ((volatile PG8_LAS unsigned*)((PG8_LAS unsigned char*)lds + LDS_MISC))[0] = 0u; ((volatile PG8_LAS unsigned*)((PG8_LAS unsigned char*)lds + LDS_MISC))[1] = 0u;
        (void)xb_add((unsigned*)(a.ws + WS_CTL) + BAR_WORD0 + XB_XCNT(xb_xcc_id()), 1u); }
    __syncthreads();
    float* out = a.out;

    prologue(a, lds, tid, lane, wave);
    if (G == 0x7fffffff) grid.sync();
    xcd_barrier((unsigned*)(a.ws + WS_CTL) + BAR_WORD0, (volatile PG8_LAS unsigned*)((PG8_LAS unsigned char*)lds + LDS_MISC));

#pragma unroll 1
    for (int op = 0; op < DEPTH * 8; ++op) {
        const int l = op >> 3, k = op & 7;
        int lane = (int)__builtin_amdgcn_mbcnt_hi(~0u, __builtin_amdgcn_mbcnt_lo(~0u, 0u)); asm volatile("" : "+v"(lane));
        const int wave = wave_s, tid = wave_s * 64 + lane;
        unsigned long long lz = 0; asm volatile("" : "+s"(lz));
        unsigned char* ws = a.ws + lz;
        Args al = a; al.ws = ws;
        float* out = a.out; bf16_t* xb = (bf16_t*)(ws + WS_XB); float* ssq = (float*)(ws + WS_SSQ); bf16_t* proj = (bf16_t*)(ws + WS_PROJ);
        const unsigned char* wl = ws + WS_W + (size_t)l * W_LAYER;
        if (k == 0 || k == 6) {
            pg8::Gemm g{xb, (const bf16_t*)(wl + (k == 0 ? WO_GU1 : WO_GU2)), M, NGU, D, D, D};
            pg8::StaticOrder S; S.init(M, NGU, G, (int)blockIdx.x);
            EpiSwiGLU E{proj, ssq};
            pg8::gemm_phase<EpiSwiGLU, true>((PG8_LAS unsigned char*)lds, g, S, E, tid);
        } else if (k == 1 || k == 7 || k == 5) {
            const bool isout = (k == 5);
            pg8::Gemm g{proj, (const bf16_t*)(wl + (k == 1 ? WO_D1 : (k == 7 ? WO_D2 : WO_OUT))), M, D, isout ? D : DFF, isout ? LD : DFF, isout ? D : DFF};
            pg8::StaticOrder S; S.init(M, D, G, (int)blockIdx.x);
            EpiResid E{xb, ssq, isout ? 1.0f : 0.5f};
            pg8::gemm_phase<EpiResid, false>((PG8_LAS unsigned char*)lds, g, S, E, tid);
        } else if (k == 2) {
            pg8::Gemm g{xb, (const bf16_t*)(wl + WO_IN), M, LD, D, D, D};
            pg8::StaticOrder S; S.init(M, LD, G, (int)blockIdx.x);
            EpiProj E{proj, ssq, (const float*)(ws + WS_ROPE), (float*)(ws + WS_FFB)};
            pg8::gemm_phase<EpiProj, true>((PG8_LAS unsigned char*)lds, g, S, E, tid);
        } else if (k == 3) {
            if (blockIdx.x < 32) fox_scan(al, l, (int)blockIdx.x, lds, tid, lane, wave);
            for (int it = blockIdx.x; it < 1024; it += G) hgrn_prep(al, l, it, lds, tid, lane, wave);
        } else {
            if (blockIdx.x < 32) hgrn_chain(al, l, (int)blockIdx.x, lds, tid, lane, wave);
            unsigned char* vl = lds + wave * 4608;
            const int x0 = (int)(blockIdx.x & 7);
#pragma unroll 1
            for (int dx = 0; dx < 8; ++dx) {
                const int x = (x0 + dx) & 7;
                unsigned* ctr = (unsigned*)(ws + WS_CTL) + 64 * (l * 8 + x);
                if (__hip_atomic_load(ctr, __ATOMIC_RELAXED, __HIP_MEMORY_SCOPE_AGENT) >= 512u) continue;
                for (;;) {
                    unsigned it = 0;
                    if (lane == 0) it = atomicAdd(ctr, 1u);
                    it = __builtin_amdgcn_readfirstlane(it);
                    if (it >= 512u) break;
                    attn_item(al, x, (int)it, vl, lane);
                }
            }
        }
        xcd_barrier((unsigned*)(ws + WS_CTL) + BAR_WORD0, (volatile PG8_LAS unsigned*)((PG8_LAS unsigned char*)lds + LDS_MISC));
    }
    {
        int lane = (int)__builtin_amdgcn_mbcnt_hi(~0u, __builtin_amdgcn_mbcnt_lo(~0u, 0u)); asm volatile("" : "+v"(lane));
        const int wave = wave_s;
        const int gw = blockIdx.x * 8 + wave, NGW = G * 8;
        const bf16_t* xbf = (const bf16_t*)(a.ws + WS_XB);
        for (int m = gw; m < M; m += NGW) {
            const u32x2* xr = (const u32x2*)(xbf + (size_t)m * D) + lane; f32x4* orow = (f32x4*)(out + (size_t)m * D) + lane; f32x4 v[4]; float s = 0.f;
#pragma unroll
            for (int j = 0; j < 4; ++j) { const u32x2 wv = xr[64 * j]; v[j] = (f32x4){__uint_as_float(wv.x << 16), __uint_as_float(wv.x & 0xffff0000u), __uint_as_float(wv.y << 16), __uint_as_float(wv.y & 0xffff0000u)};
                s += (v[j][0] * v[j][0] + v[j][1] * v[j][1]) + (v[j][2] * v[j][2] + v[j][3] * v[j][3]); }
#pragma unroll
            for (int o = 1; o < 64; o <<= 1) s += shfl_lane(s, lane ^ o);
            const float rs = 1.0f / sqrtf(s * (1.0f / D) + EPS);
#pragma unroll
            for (int j = 0; j < 4; ++j) { const f32x4 gn = ((const f32x4*)a.fn)[lane + 64 * j]; orow[64 * j] = v[j] * rs * gn; }
        }
    }
}

extern "C" void kernel_launch(void* const* d_in, const int* in_sizes, int n_in, void* d_out, int out_size, void* d_ws, size_t ws_size, hipStream_t stream) {
    static int grid = 0;
    if (grid == 0) {
        if (n_in != 17 || out_size != M * D || ws_size < WS_END) { fprintf(stderr, "kernel_launch: unexpected shapes / workspace (n_in %d out %d ws %zu)\n", n_in, out_size, ws_size); grid = -1; return; }
        int dev = 0, cus = 0, per_cu = 0;
        (void)hipGetDevice(&dev);
        (void)hipDeviceGetAttribute(&cus, hipDeviceAttributeMultiprocessorCount, dev);
        (void)hipFuncSetAttribute((const void*)fwd_megakernel, hipFuncAttributeMaxDynamicSharedMemorySize, LDS_BYTES);
        (void)hipOccupancyMaxActiveBlocksPerMultiprocessor(&per_cu, (const void*)fwd_megakernel, 512, LDS_BYTES);
        (void)hipGetLastError();
        if (per_cu < 1) per_cu = 1;
        grid = cus * per_cu;
    }
    if (grid < 0) return;
    (void)hipMemsetAsync((char*)d_ws + WS_CTL, 0, 32768, stream);
    Args a{};
    a.x = (const float*)d_in[0]; a.pos = (const int*)d_in[1];
    a.f1n = (const float*)d_in[2]; a.f1g = (const float*)d_in[3]; a.f1u = (const float*)d_in[4]; a.f1d = (const float*)d_in[5];
    a.mn = (const float*)d_in[6]; a.win = (const float*)d_in[7]; a.fb = (const float*)d_in[8]; a.hlb = (const float*)d_in[9]; a.hon = (const float*)d_in[10];
    a.wout = (const float*)d_in[11]; a.f2n = (const float*)d_in[12]; a.f2g = (const float*)d_in[13]; a.f2u = (const float*)d_in[14]; a.f2d = (const float*)d_in[15];
    a.fn = (const float*)d_in[16];
    a.out = (float*)d_out; a.ws = (unsigned char*)d_ws;
    void* args[] = {&a};
    hipError_t e = hipLaunchCooperativeKernel((const void*)fwd_megakernel, dim3(grid), dim3(512), args, LDS_BYTES, stream);
    if (e != hipSuccess) fprintf(stderr, "cooperative launch failed: %s (grid %d)\n", hipGetErrorString(e), grid);
}
```
